# Optimizing an MI355X kernel written in HIP

```python
import jax, jax.numpy as jnp
from jax import lax
import numpy as np


D_MODEL = 1024
BATCH = 16
SEQ = 2048
DEPTH = 4
DEC_BATCH = 1
DEC_SEQ = 16384
PAST_LEN = 128

D_MIX = D_MODEL
D_A = D_MIX // 2
D_B = D_MIX - D_A
A_HEADS = 4
A_HEAD_DIM = D_A // A_HEADS
CHUNK = 128
B_HEAD_DIM = 64
B_HEADS = D_B // B_HEAD_DIM
DECAY_LORA = 64
AAA_LORA = 64
GATE_LORA = 128
N_DIR = 2
D_FF = (8 * D_MODEL + 3 * 256 - 1) // (3 * 256) * 256
P_A = 2 * D_A
P_B = 3 * D_B + N_DIR * DECAY_LORA + N_DIR * AAA_LORA + GATE_LORA
P_IN = P_A + P_B
N_MOD = 6
EPS = 1e-6
GN_EPS = 64e-5

kernel_name = 'hymba_gmlp_rwkv7_bidir_adaln_encoder'


def _rmsnorm(x, g):
    xf = x.astype(jnp.float32)
    xf = xf * lax.rsqrt(jnp.mean(xf * xf, axis=-1, keepdims=True) + EPS)
    return (xf * g.astype(jnp.float32)).astype(x.dtype)


def _modulate(h, shift, scale):
    return h * (1 + scale[:, None, :]) + shift[:, None, :]


def _token_shift(p, mu):
    p_prev = jnp.pad(p[:, :-1], ((0, 0), (1, 0), (0, 0)))
    p_next = jnp.pad(p[:, 1:], ((0, 0), (0, 1), (0, 0)))
    return p + mu[0] * (p_prev - p) + mu[1] * (p_next - p)


def _mixer_a(pa, ln_w, ln_b, w_s, b_s, out_g):
    bsz, seq, _ = pa.shape
    n_chunks = seq // CHUNK
    pa = jax.nn.gelu(pa, approximate=False)
    u, v = jnp.split(pa, 2, axis=-1)
    shp = (bsz, n_chunks, CHUNK, A_HEADS, A_HEAD_DIM)
    vf = v.reshape(shp).astype(jnp.float32)
    mu = jnp.mean(vf, -1, keepdims=True)
    var = jnp.mean(jnp.square(vf - mu), -1, keepdims=True)
    vn = ((vf - mu) * lax.rsqrt(var + EPS) * ln_w.reshape(A_HEADS, A_HEAD_DIM)
          + ln_b.reshape(A_HEADS, A_HEAD_DIM)).astype(pa.dtype)
    z = jnp.einsum('hpq,bcqhd->bcphd', w_s, vn) + b_s.T[:, :, None]
    o = (u.reshape(shp) * z).astype(jnp.float32)
    o = o * lax.rsqrt(jnp.mean(o * o, -1, keepdims=True) + EPS) * out_g.reshape(A_HEADS, A_HEAD_DIM)
    return o.reshape(bsz, seq, D_A).astype(pa.dtype)


def _heads(t):
    return t.reshape(t.shape[:-1] + (B_HEADS, B_HEAD_DIM))


def _dir_to_time_major(t):
    t = jnp.stack([t[:, :, 0], jnp.flip(t[:, :, 1], axis=1)], axis=0)
    return jnp.transpose(t, (2, 0, 1, 3, 4))


def _wkv_step(state, inp):
    r_t, w_t, k_t, v_t, kk_t, b_t = inp
    s_kk = jnp.einsum('dbhvk,dbhk->dbhv', state, kk_t)
    state = (state * w_t[..., None, :] - s_kk[..., :, None] * b_t[..., None, :]
             + v_t[..., :, None] * k_t[..., None, :])
    y = jnp.einsum('dbhvk,dbhk->dbhv', state, r_t)
    return state, y


def _mixer_b(pb, shift_mu, w0, w2, a0, a2, g2, k_k, k_a, r_k, lnx_w, lnx_b):
    f32 = jnp.float32
    dt = pb.dtype
    bsz, seq, _ = pb.shape
    pb = _token_shift(pb, shift_mu)
    splits = [D_B, 2 * D_B, 3 * D_B, 3 * D_B + N_DIR * DECAY_LORA,
              3 * D_B + N_DIR * (DECAY_LORA + AAA_LORA)]
    r, k, v, dw, da, dg = jnp.split(pb, splits, axis=-1)
    dw = dw.reshape(bsz, seq, N_DIR, DECAY_LORA)
    da = da.reshape(bsz, seq, N_DIR, AAA_LORA)
    logw = -jax.nn.softplus(-(w0 + jnp.einsum('bsnl,nlc->bsnc', jnp.tanh(dw), w2))) - 0.5
    decay = jnp.exp(-jnp.exp(logw.astype(f32)))
    a = jax.nn.sigmoid(a0 + jnp.einsum('bsnl,nlc->bsnc', da, a2))
    g = jax.nn.sigmoid(dg) @ g2
    kk = _heads((k * k_k).astype(f32))
    kk = kk / jnp.maximum(jnp.sqrt(jnp.sum(kk * kk, -1, keepdims=True)), 1e-12)
    k_dir = _heads((k[:, :, None, :] * (1 + (a - 1) * k_a)).astype(f32))
    b_dir = kk[:, :, None] * _heads(a.astype(f32))
    r_h = _heads(r.astype(f32))
    v_h = _heads(v.astype(f32))
    shape5 = (bsz, seq, N_DIR, B_HEADS, B_HEAD_DIM)
    xs = (_dir_to_time_major(jnp.broadcast_to(r_h[:, :, None], shape5)),
          _dir_to_time_major(_heads(decay)),
          _dir_to_time_major(k_dir),
          _dir_to_time_major(jnp.broadcast_to(v_h[:, :, None], shape5)),
          _dir_to_time_major(jnp.broadcast_to(kk[:, :, None], shape5)),
          _dir_to_time_major(b_dir))
    s0 = jnp.zeros((N_DIR, bsz, B_HEADS, B_HEAD_DIM, B_HEAD_DIM), f32)
    _, ys = lax.scan(_wkv_step, s0, xs)
    y = ys[:, 0] + jnp.flip(ys[:, 1], axis=0)
    y = jnp.transpose(y, (1, 0, 2, 3))
    mu = jnp.mean(y, -1, keepdims=True)
    var = jnp.mean(jnp.square(y - mu), -1, keepdims=True)
    yn = (y - mu) * lax.rsqrt(var + GN_EPS) * _heads(lnx_w.astype(f32)) + _heads(lnx_b.astype(f32))
    bonus = jnp.sum(r_h * (k_dir[:, :, 0] + k_dir[:, :, 1]) * _heads(r_k.astype(f32)), -1, keepdims=True) * v_h
    out = (yn + bonus).reshape(bsz, seq, D_B) * g.astype(f32)
    return out.astype(dt)


def _layer(x, c, ada_w, ada_b, norm1_g, w_in, sgu_ln_w, sgu_ln_b, w_spatial, b_spatial, a_out_g,
           shift_mu, w0, w2, a0, a2, g2, k_k, k_a, r_k, lnx_w, lnx_b, w_out, norm2_g, w_gu, w_down):
    mod = jax.nn.silu(c) @ ada_w + ada_b
    sh1, sc1, gt1, sh2, sc2, gt2 = jnp.split(mod, N_MOD, axis=-1)
    h = _modulate(_rmsnorm(x, norm1_g), sh1, sc1)
    p = h @ w_in
    ya = _mixer_a(p[..., :P_A], sgu_ln_w, sgu_ln_b, w_spatial, b_spatial, a_out_g)
    yb = _mixer_b(p[..., P_A:], shift_mu, w0, w2, a0, a2, g2, k_k, k_a, r_k, lnx_w, lnx_b)
    x = x + gt1[:, None, :] * (jnp.concatenate([ya, yb], axis=-1) @ w_out)
    h = _modulate(_rmsnorm(x, norm2_g), sh2, sc2)
    gate, up = jnp.split(h @ w_gu, 2, axis=-1)
    x = x + gt2[:, None, :] * ((jax.nn.silu(gate) * up) @ w_down)
    return x


def _trunk(x, c, ada_w, ada_b, norm1_g, w_in, sgu_ln_w, sgu_ln_b, w_spatial, b_spatial, a_out_g,
           shift_mu, w0, w2, a0, a2, g2, k_k, k_a, r_k, lnx_w, lnx_b, w_out, norm2_g, w_gu, w_down,
           final_g):
    for l in range(DEPTH):
        x = _layer(x, c, ada_w[l], ada_b[l], norm1_g[l], w_in[l], sgu_ln_w[l], sgu_ln_b[l],
                   w_spatial[l], b_spatial[l], a_out_g[l], shift_mu[l], w0[l], w2[l], a0[l], a2[l],
                   g2[l], k_k[l], k_a[l], r_k[l], lnx_w[l], lnx_b[l], w_out[l], norm2_g[l],
                   w_gu[l], w_down[l])
    return _rmsnorm(x, final_g)


def setup_inputs(seed: int = 0) -> dict:
    key = jax.random.key(seed)
    ks = iter(jax.random.split(key, 40))
    f32 = jnp.float32
    L, D = DEPTH, D_MODEL

    def nrm(shape, s):
        return jax.random.normal(next(ks), shape, f32) * s

    def uni(shape, lo, hi):
        return jax.random.uniform(next(ks), shape, f32, lo, hi)

    return {
        'x_prompt': nrm((BATCH, SEQ, D), 1.0),
        'x_sample': nrm((DEC_BATCH, DEC_SEQ, D), 1.0),
        'c_prompt': nrm((BATCH, D), 1.0),
        'c_sample': nrm((DEC_BATCH, D), 1.0),
        'ada_w': nrm((L, D, N_MOD * D), 0.2 * D ** -0.5),
        'ada_b': nrm((L, N_MOD * D), 0.05),
        'norm1_g': 1.0 + nrm((L, D), 0.02),
        'w_in': nrm((L, D, P_IN), D ** -0.5),
        'sgu_ln_w': 1.0 + nrm((L, D_A), 0.02),
        'sgu_ln_b': nrm((L, D_A), 0.02),
        'w_spatial': nrm((L, A_HEADS, CHUNK, CHUNK), CHUNK ** -0.5),
        'b_spatial': 1.0 + nrm((L, A_HEADS, CHUNK), 0.02),
        'a_out_g': 1.0 + nrm((L, D_A), 0.02),
        'shift_mu': uni((L, 2, P_B), 0.0, 0.5),
        'w0': uni((L, N_DIR, D_B), -4.0, 1.0),
        'w2': nrm((L, N_DIR, DECAY_LORA, D_B), 0.1 * DECAY_LORA ** -0.5),
        'a0': nrm((L, N_DIR, D_B), 0.1),
        'a2': nrm((L, N_DIR, AAA_LORA, D_B), 0.1 * AAA_LORA ** -0.5),
        'g2': nrm((L, GATE_LORA, D_B), GATE_LORA ** -0.5),
        'k_k': 0.85 + nrm((L, D_B), 0.02),
        'k_a': 1.0 + nrm((L, D_B), 0.02),
        'r_k': nrm((L, D_B), 0.1),
        'lnx_w': 1.0 + nrm((L, D_B), 0.02),
        'lnx_b': nrm((L, D_B), 0.02),
        'w_out': nrm((L, D_MIX, D), D_MIX ** -0.5),
        'norm2_g': 1.0 + nrm((L, D), 0.02),
        'w_gu': nrm((L, D, 2 * D_FF), D ** -0.5),
        'w_down': nrm((L, D_FF, D), D_FF ** -0.5),
        'final_g': 1.0 + nrm((D,), 0.02),
    }


def reference(x_prompt, x_sample, c_prompt, c_sample, ada_w, ada_b, norm1_g, w_in, sgu_ln_w, sgu_ln_b,
              w_spatial, b_spatial, a_out_g, shift_mu, w0, w2, a0, a2, g2, k_k, k_a, r_k, lnx_w, lnx_b,
              w_out, norm2_g, w_gu, w_down, final_g):
    y_prompt = _trunk(x_prompt, c_prompt, ada_w, ada_b, norm1_g, w_in, sgu_ln_w, sgu_ln_b, w_spatial,
                      b_spatial, a_out_g, shift_mu, w0, w2, a0, a2, g2, k_k, k_a, r_k, lnx_w, lnx_b,
                      w_out, norm2_g, w_gu, w_down, final_g)
    y_sample = _trunk(x_sample, c_sample, ada_w, ada_b, norm1_g, w_in, sgu_ln_w, sgu_ln_b, w_spatial,
                      b_spatial, a_out_g, shift_mu, w0, w2, a0, a2, g2, k_k, k_a, r_k, lnx_w, lnx_b,
                      w_out, norm2_g, w_gu, w_down, final_g)
    return (y_prompt, y_sample)
```

```cpp
#include <hip/hip_runtime.h>
#include <hip/hip_cooperative_groups.h>
#include <cstdio>
#include <cstdint>
namespace cg = cooperative_groups;
namespace pg8 {
#define PG8_LAS __attribute__((address_space(3)))
typedef unsigned short bf16_t;
typedef short bf16x8 __attribute__((ext_vector_type(8)));
typedef float f32x4 __attribute__((ext_vector_type(4)));
typedef unsigned u32x4 __attribute__((ext_vector_type(4)));
constexpr int BM = 256, BK = 64, HALF = 128, HTB = HALF * BK * 2  , STAGE_BYTES = 8 * HTB, NXCD = 8, WGM = 8;

__host__ __device__ __forceinline__ int lds_byte(int r, int c) { const int st = (r >> 4) * 2 + (c >> 5), rr = r & 15, cc = c & 31, ob = rr * 64 + cc * 2; return st * 1024 + (ob ^ (((ob >> 9) & 1) << 5)); }
__host__ __device__ __forceinline__ void stage_rc(int b, int& R, int& C) { const int st = b / 1024, sb = b % 1024, swz = sb ^ (((sb >> 9) & 1) << 5); R = (st >> 1) * 16 + swz / 64; C = (st & 1) * 32 + (swz % 64) / 2; }
__host__ __device__ __forceinline__ int perm32(int rho) { const int n = rho >> 4, i = rho & 15; return 8 * (i >> 2) + 4 * n + (i & 3); }

struct Unit { int pm, pn; };
struct Gemm { const bf16_t* A; const bf16_t* Bt; int M, N, K; };

struct StaticOrder {
    int nM, nN, nwg, G, c;
    __host__ __device__ void init(int M, int N, int G_, int c_) { nM = M / BM; nN = N / BM; nwg = nM * nN; G = G_; c = c_; }
    __host__ __device__ bool next(int i, Unit& u) const {
        const long L = (long)i * G + c; if (L >= nwg) return false;
        int wgid = (int)L; { const int q = nwg / NXCD, r = nwg % NXCD, xcd = wgid % NXCD, off = wgid / NXCD; wgid = (xcd < r ? xcd * (q + 1) : r * (q + 1) + (xcd - r) * q) + off; }
        const int nig = WGM * nN, gid = wgid / nig, fm = gid * WGM, gsz = (nM - fm) < WGM ? (nM - fm) : WGM;
        u.pm = fm + ((wgid % nig) % gsz); u.pn = (wgid % nig) / gsz; return true;
    }
    __device__ __forceinline__ void a_ready(const Unit&) const {}
    __device__ __forceinline__ void done(const Unit&) const {}
};


typedef __bf16 bf16v2_t __attribute__((ext_vector_type(2)));
typedef float f32v2_t __attribute__((ext_vector_type(2)));
__device__ __forceinline__ unsigned cvt_pk_bf16(float lo, float hi) { const f32v2_t v = {lo, hi}; const bf16v2_t b = __builtin_convertvector(v, bf16v2_t); return __builtin_bit_cast(unsigned, b); }
__device__ __forceinline__ int batch_of_row(int row) { return row < 32768 ? (row >> 11) : 16; }

struct EpiBf16 {
    static constexpr bool PERM = true, AFTER_DRAIN = false;
    bf16_t* O; int ldc;
    __device__ __forceinline__ void operator()(const f32x4 (&acc)[2][2][4][2], const Unit& u, int wr, int wc, int fr, int fq) const {
        const int row0 = u.pm * BM + wr * 64 + fr; const int col0 = u.pn * BM + wc * 32 + 8 * fq;
#pragma unroll
        for (int ai = 0; ai < 2; ++ai)
#pragma unroll
            for (int m = 0; m < 4; ++m) { bf16_t* rowp = O + (size_t)(row0 + ai * HALF + m * 16) * ldc + col0;
#pragma unroll
                for (int bj = 0; bj < 2; ++bj) { const f32x4 v0 = acc[ai][bj][m][0], v1 = acc[ai][bj][m][1];
                    u32x4 w; w.x = cvt_pk_bf16(v0[0], v0[1]); w.y = cvt_pk_bf16(v0[2], v0[3]); w.z = cvt_pk_bf16(v1[0], v1[1]); w.w = cvt_pk_bf16(v1[2], v1[3]);
                    *(u32x4*)(rowp + bj * HALF) = w; } }
    }
};
__device__ __forceinline__ float silu_f(float g) { return g * __builtin_amdgcn_rcpf(1.f + __expf(-g)); }
struct EpiSwiGLU {
    static constexpr bool PERM = true, AFTER_DRAIN = false;
    bf16_t* O;
    __device__ __forceinline__ void operator()(const f32x4 (&acc)[2][2][4][2], const Unit& u, int wr, int wc, int fr, int fq) const {
        const int row0 = u.pm * BM + wr * 64 + fr; const int col0 = u.pn * 128 + wc * 32 + 8 * fq;
#pragma unroll
        for (int ai = 0; ai < 2; ++ai)
#pragma unroll
            for (int m = 0; m < 4; ++m) { bf16_t* rowp = O + (size_t)(row0 + ai * HALF + m * 16) * 2816 + col0;
                const f32x4 g0 = acc[ai][0][m][0], g1 = acc[ai][0][m][1], u0 = acc[ai][1][m][0], u1 = acc[ai][1][m][1];
                u32x4 w;
                w.x = cvt_pk_bf16(silu_f(g0[0]) * u0[0], silu_f(g0[1]) * u0[1]); w.y = cvt_pk_bf16(silu_f(g0[2]) * u0[2], silu_f(g0[3]) * u0[3]);
                w.z = cvt_pk_bf16(silu_f(g1[0]) * u1[0], silu_f(g1[1]) * u1[1]); w.w = cvt_pk_bf16(silu_f(g1[2]) * u1[2], silu_f(g1[3]) * u1[3]);
                *(u32x4*)rowp = w; }
    }
};
struct EpiRes {
    static constexpr bool PERM = false, AFTER_DRAIN = false;
    const float* base_a; const float* base_b; float* out; const float* gate;
    __device__ __forceinline__ void operator()(const f32x4 (&acc)[2][2][4][2], const Unit& u, int wr, int wc, int fr, int fq) const {
        const int row0 = u.pm * BM + wr * 64 + fr; const int b = batch_of_row(u.pm * BM); const int col0 = u.pn * BM + wc * 32 + 4 * fq;
        f32x4 gv[2][2];
#pragma unroll
        for (int bj = 0; bj < 2; ++bj)
#pragma unroll
            for (int n = 0; n < 2; ++n) gv[bj][n] = *(const f32x4*)(gate + (size_t)b * 6144 + col0 + bj * HALF + n * 16);
#pragma unroll
        for (int ai = 0; ai < 2; ++ai)
#pragma unroll
            for (int m = 0; m < 4; ++m) { const int row = row0 + ai * HALF + m * 16;
                const float* bp = row < 32768 ? base_a + (size_t)row * 1024 : base_b + (size_t)(row - 32768) * 1024; float* op = out + (size_t)row * 1024;
#pragma unroll
                for (int bj = 0; bj < 2; ++bj)
#pragma unroll
                    for (int n = 0; n < 2; ++n) { const int c = col0 + bj * HALF + n * 16; const f32x4 o = *(const f32x4*)(bp + c) + gv[bj][n] * acc[ai][bj][m][n]; *(f32x4*)(op + c) = o; }
                if (m & 1) asm volatile("" ::: "memory"); }
    }
};

template <class Epi, class Sched, bool ALIGN_EPI = false, bool SP2 = false>
__device__ __forceinline__ void gemm_phase(PG8_LAS unsigned char* lds, const Gemm g, const Sched& S, const Epi& E, int tid_in) {
    int tid_ = tid_in; asm volatile("" : "+v"(tid_)); const int tid = tid_, wid = __builtin_amdgcn_readfirstlane(tid >> 6), lane = tid & 63, wr = wid >> 2, wc = wid & 3, fr = lane & 15, fq = lane >> 4;
    const int K = g.K, nt = K / BK;
    unsigned voffA[2], voffB[2];
#pragma unroll
    for (int i = 0; i < 2; ++i) { int R, C; stage_rc(tid * 16 + i * 8192, R, C); const int Rb = Epi::PERM ? ((R & ~31) + perm32(R & 31)) : R;
        voffA[i] = (unsigned)(R * K + C) * 2u; voffB[i] = (unsigned)(Rb * K + C) * 2u; }
    const size_t kstep = (size_t)(BK * 2);
    const size_t hstep = (size_t)HALF * K * 2;
    const size_t tstep = 2 * hstep;
    const unsigned ldsw = (unsigned)wid * 1024u;
    const int aoff = lds_byte(wr * 64 + fr, fq * 8), boff = lds_byte(wc * 32 + fr, fq * 8);
#define PG8_SA(b, h) (((b) * 2 + (h)) * HTB)
#define PG8_SB(b, h) ((4 + (b) * 2 + (h)) * HTB)
#define PG8_STAGE(bufoff, gbase, voff) do { _Pragma("unroll") for (int _i = 0; _i < 2; ++_i) \
        __builtin_amdgcn_global_load_lds((const unsigned*)((const char*)(gbase) + (voff)[_i]), (PG8_LAS unsigned*)(lds + (bufoff) + ldsw + _i * 8192), 16, 0, 0); } while (0)
#define PG8_LDA(dst, b, h) do { _Pragma("unroll") for (int m = 0; m < 4; ++m) _Pragma("unroll") for (int k = 0; k < 2; ++k) dst[m][k] = *(const PG8_LAS bf16x8*)(lds + PG8_SA(b, h) + aoff + m * 2048 + k * 1024); } while (0)
#define PG8_LDB(dst, b, h) do { _Pragma("unroll") for (int n = 0; n < 2; ++n) _Pragma("unroll") for (int k = 0; k < 2; ++k) dst[n][k] = *(const PG8_LAS bf16x8*)(lds + PG8_SB(b, h) + boff + n * 2048 + k * 1024); } while (0)
#define PG8_MMA(ai, bj, At, Bt) do { __builtin_amdgcn_s_setprio(1); _Pragma("unroll") for (int m = 0; m < 4; ++m) _Pragma("unroll") for (int n = 0; n < 2; ++n) _Pragma("unroll") for (int k = 0; k < 2; ++k) \
        acc[ai][bj][m][n] = __builtin_amdgcn_mfma_f32_16x16x32_bf16(Bt[n][k], At[m][k], acc[ai][bj][m][n], 0, 0, 0); __builtin_amdgcn_s_setprio(0); } while (0)
#define PG8_WAIT_V(n) asm volatile("s_waitcnt vmcnt(" #n ")" ::: "memory")
#define PG8_WAIT_L(n) asm volatile("s_waitcnt lgkmcnt(" #n ")" ::: "memory")
#define PG8_BAR __builtin_amdgcn_s_barrier()
#define PG8_SCHED __builtin_amdgcn_sched_barrier(0)
    Unit cur, nxt; int ui = 0;
    if (!S.next(0, cur)) return;
    f32x4 acc[2][2][4][2];
#pragma unroll
    for (int a = 0; a < 2; ++a)
#pragma unroll
        for (int b = 0; b < 2; ++b)
#pragma unroll
            for (int m = 0; m < 4; ++m)
#pragma unroll
                for (int n = 0; n < 2; ++n) acc[a][b][m][n] = (f32x4){0.f, 0.f, 0.f, 0.f};
    bf16x8 At[4][2], B0[2][2], B1[2][2];
    const char* cA = (const char*)g.A + (size_t)cur.pm * tstep; const char* cB = (const char*)g.Bt + (size_t)cur.pn * tstep;
    S.a_ready(cur);
    if constexpr (SP2) {
        PG8_STAGE(PG8_SB(0, 0), cB, voffB); PG8_STAGE(PG8_SB(0, 1), cB + hstep, voffB); PG8_STAGE(PG8_SA(0, 0), cA, voffA); PG8_STAGE(PG8_SA(0, 1), cA + hstep, voffA);
        if (wr == 1) PG8_BAR;
        PG8_WAIT_V(2); PG8_BAR;
        PG8_STAGE(PG8_SB(1, 0), cB + kstep, voffB); PG8_STAGE(PG8_SA(1, 0), cA + kstep, voffA); PG8_STAGE(PG8_SB(1, 1), cB + hstep + kstep, voffB);
        PG8_WAIT_V(6); PG8_BAR;
    } else {
        PG8_STAGE(PG8_SB(0, 0), cB, voffB); PG8_STAGE(PG8_SA(0, 0), cA, voffA); PG8_STAGE(PG8_SB(0, 1), cB + hstep, voffB); PG8_STAGE(PG8_SA(0, 1), cA + hstep, voffA);
        if (wr == 1) PG8_BAR;
        PG8_WAIT_V(4); PG8_BAR;
        PG8_STAGE(PG8_SB(1, 0), cB + kstep, voffB); PG8_STAGE(PG8_SA(1, 0), cA + kstep, voffA); PG8_STAGE(PG8_SB(1, 1), cB + hstep + kstep, voffB);
        PG8_WAIT_V(6); PG8_BAR;
    }
    for (;;) {
        const bool has_next = S.next(ui + 1, nxt);
        const char* nA = has_next ? (const char*)g.A + (size_t)nxt.pm * tstep : cA; const char* nB = has_next ? (const char*)g.Bt + (size_t)nxt.pn * tstep : cB;
        for (int t = 0; t < nt; t += 2) {
            const bool last = (t == nt - 2);
            const char* a1 = cA + (size_t)(t + 1) * kstep;
            const char* a2 = last ? nA : cA + (size_t)(t + 2) * kstep; const char* b2 = last ? nB : cB + (size_t)(t + 2) * kstep;
            const char* a3 = a2 + kstep; const char* b3 = b2 + kstep;
            if (last && has_next) S.a_ready(nxt);
            if constexpr (SP2) {
            PG8_LDB(B0, 0, 0); PG8_LDB(B1, 0, 1); PG8_SCHED; PG8_LDA(At, 0, 0); PG8_STAGE(PG8_SA(1, 1), a1 + hstep, voffA);
            PG8_WAIT_V(8); PG8_WAIT_L(0); PG8_BAR; PG8_MMA(0, 0, At, B0); PG8_MMA(0, 1, At, B1); PG8_BAR; PG8_SCHED;
            PG8_LDA(At, 0, 1); PG8_STAGE(PG8_SB(0, 0), b2, voffB); PG8_STAGE(PG8_SB(0, 1), b2 + hstep, voffB); PG8_STAGE(PG8_SA(0, 0), a2, voffA);
            PG8_WAIT_V(8); PG8_WAIT_L(0); PG8_BAR; PG8_MMA(1, 0, At, B0); PG8_MMA(1, 1, At, B1); PG8_BAR; PG8_SCHED;
            PG8_LDB(B0, 1, 0); PG8_LDB(B1, 1, 1); PG8_SCHED; PG8_LDA(At, 1, 0); PG8_STAGE(PG8_SA(0, 1), a2 + hstep, voffA);
            PG8_WAIT_V(8); PG8_WAIT_L(0); PG8_BAR; PG8_MMA(0, 0, At, B0); PG8_MMA(0, 1, At, B1); PG8_BAR; PG8_SCHED;
            PG8_LDA(At, 1, 1); PG8_STAGE(PG8_SB(1, 0), b3, voffB); PG8_STAGE(PG8_SB(1, 1), b3 + hstep, voffB); PG8_STAGE(PG8_SA(1, 0), a3, voffA);
            PG8_WAIT_V(8); PG8_WAIT_L(0); PG8_BAR; PG8_MMA(1, 0, At, B0); PG8_MMA(1, 1, At, B1); PG8_BAR; PG8_SCHED;
            } else {
            PG8_LDB(B0, 0, 0); PG8_SCHED; PG8_LDA(At, 0, 0); PG8_STAGE(PG8_SA(1, 1), a1 + hstep, voffA);
            PG8_WAIT_L(8); PG8_BAR; PG8_WAIT_L(0); PG8_MMA(0, 0, At, B0); PG8_BAR; PG8_SCHED;
            PG8_LDB(B1, 0, 1); PG8_STAGE(PG8_SB(0, 0), b2, voffB);
            PG8_BAR; PG8_WAIT_L(0); PG8_MMA(0, 1, At, B1); PG8_BAR;
            PG8_LDA(At, 0, 1); PG8_STAGE(PG8_SA(0, 0), a2, voffA);
            PG8_BAR; PG8_WAIT_L(0); PG8_MMA(1, 0, At, B0); PG8_BAR; PG8_SCHED;
            PG8_STAGE(PG8_SB(0, 1), b2 + hstep, voffB);
            PG8_WAIT_V(6); PG8_BAR; PG8_MMA(1, 1, At, B1); PG8_BAR;
            PG8_LDB(B0, 1, 0); PG8_SCHED; PG8_LDA(At, 1, 0); PG8_STAGE(PG8_SA(0, 1), a2 + hstep, voffA);
            PG8_WAIT_L(8); PG8_BAR; PG8_WAIT_L(0); PG8_MMA(0, 0, At, B0); PG8_BAR; PG8_SCHED;
            PG8_LDB(B1, 1, 1); PG8_STAGE(PG8_SB(1, 0), b3, voffB);
            PG8_BAR; PG8_WAIT_L(0); PG8_MMA(0, 1, At, B1); PG8_BAR;
            PG8_LDA(At, 1, 1); PG8_STAGE(PG8_SA(1, 0), a3, voffA);
            PG8_BAR; PG8_WAIT_L(0); PG8_MMA(1, 0, At, B0); PG8_BAR; PG8_SCHED;
            PG8_STAGE(PG8_SB(1, 1), b3 + hstep, voffB);
            PG8_WAIT_V(6); PG8_BAR; PG8_MMA(1, 1, At, B1); PG8_BAR;
            }
        }
        if constexpr (ALIGN_EPI) { if (wr == 0) PG8_BAR; }
        if constexpr (!Epi::AFTER_DRAIN) { E(acc, cur, wr, wc, fr, fq); S.done(cur); }
        if (!has_next) break;
#pragma unroll
        for (int a = 0; a < 2; ++a)
#pragma unroll
            for (int b = 0; b < 2; ++b)
#pragma unroll
                for (int m = 0; m < 4; ++m)
#pragma unroll
                    for (int n = 0; n < 2; ++n) acc[a][b][m][n] = (f32x4){0.f, 0.f, 0.f, 0.f};
        cur = nxt; cA = nA; cB = nB; ++ui;
        if constexpr (ALIGN_EPI) { if (wr == 1) PG8_BAR; }
    }
    PG8_WAIT_V(0);
    if constexpr (!ALIGN_EPI) { if (wr == 0) PG8_BAR; }
    PG8_BAR;
    if constexpr (Epi::AFTER_DRAIN) { E.fused(acc, cur, wr, wc, fr, fq, lds, wid, lane); S.done(cur); }
#undef PG8_SA
#undef PG8_SB
#undef PG8_STAGE
#undef PG8_LDA
#undef PG8_LDB
#undef PG8_MMA
#undef PG8_WAIT_V
#undef PG8_WAIT_L
#undef PG8_BAR
#undef PG8_SCHED
}
}

constexpr int MTOK = 49152, DM = 1024, NBATCH = 17, NLAYER = 4, PIN = 2944, PLD = 3072, DFF = 2816, NMOD = 6144;
constexpr int NWAVES = 8, NTHR = 512;
constexpr float EPS_F = 1e-6f, GN_EPS_F = 64e-5f;
constexpr size_t MiB = 1u << 20;
constexpr size_t WS_MOD = 1 * MiB;
constexpr size_t WS_WIN = 3 * MiB;
constexpr size_t WS_WOUT = 9 * MiB;
constexpr size_t WS_WGU = 11 * MiB;
constexpr size_t WS_WDN = 22 * MiB;
constexpr size_t WS_WSP = 27 * MiB + 512 * 1024;
constexpr size_t WS_XN = 28 * MiB;
constexpr size_t WS_P = 124 * MiB;
constexpr size_t WS_SB = 508 * MiB;
constexpr size_t WS_LORA = 444 * MiB;
constexpr size_t WS_END = 510 * MiB;
constexpr int LDS_BYTES = 151552;

#define LAS __attribute__((address_space(3)))
typedef unsigned short bf16;
typedef unsigned v4u __attribute__((ext_vector_type(4)));
typedef unsigned v2u __attribute__((ext_vector_type(2)));
typedef float f32x4 __attribute__((ext_vector_type(4)));
typedef float f32x16 __attribute__((ext_vector_type(16)));
typedef short bf16x8 __attribute__((ext_vector_type(8)));
#define LDS_WAIT() asm volatile("s_waitcnt lgkmcnt(0)" ::: "memory")
typedef __bf16 bf16v2_t __attribute__((ext_vector_type(2)));
typedef float f32v2_t __attribute__((ext_vector_type(2)));
__device__ __forceinline__ unsigned pk2(float lo, float hi) { const f32v2_t v = {lo, hi}; const bf16v2_t b = __builtin_convertvector(v, bf16v2_t); return __builtin_bit_cast(unsigned, b); }
__device__ __forceinline__ unsigned f2bf(float f) { return pk2(f, f) & 0xffffu; }
__device__ __forceinline__ float bf2f(unsigned h) { return __builtin_bit_cast(float, h << 16); }
__device__ __forceinline__ float ldbf(const bf16* p) { return bf2f((unsigned)*p); }
template <int CTRL> __device__ __forceinline__ float dpp_f(float v) { return __builtin_bit_cast(float, __builtin_amdgcn_update_dpp(0, __builtin_bit_cast(int, v), CTRL, 0xF, 0xF, true)); }
typedef float f32x2 __attribute__((ext_vector_type(2)));
__device__ __forceinline__ float red16(float p) { p += dpp_f<0xB1>(p); p += dpp_f<0x4E>(p); p += dpp_f<0x141>(p); p += dpp_f<0x140>(p); return p; }
__device__ __forceinline__ float wave_sum(float v) {
    v = red16(v); const int x = __builtin_bit_cast(int, v);
    const float a = __builtin_bit_cast(float, __builtin_amdgcn_readlane(x, 0)), b = __builtin_bit_cast(float, __builtin_amdgcn_readlane(x, 16)), c = __builtin_bit_cast(float, __builtin_amdgcn_readlane(x, 32)), d = __builtin_bit_cast(float, __builtin_amdgcn_readlane(x, 48));
    return (a + b) + (c + d);
}
__device__ __forceinline__ float red8(float p) { p += dpp_f<0xB1>(p); p += dpp_f<0x4E>(p); p += dpp_f<0x141>(p); return p; }
__device__ __forceinline__ float gelu_f(float v) {
    const float t = __builtin_amdgcn_rcpf(fabsf(v) * 0.2316418882f + 1.0f);
    float q = t * 0.5307027145f + (-0.7265760135f); q = q * t + 0.7107068705f; q = q * t + (-0.142248368f); q = q * t + 0.127414796f; q = q * t;
    const float e = __builtin_amdgcn_exp2f((v * v) * (-0.72134752044f)); const float m = v * (q * e);
    return v < 0.f ? m : v - m;
}
__device__ __forceinline__ float sigmoid_f(float x) { return 1.f / (1.f + __expf(-x)); }

struct Args { const float* in[29]; float* out; unsigned char* ws; int ph_lo, ph_hi; };

__device__ __forceinline__ void transpose_item(const float* W, int K, int N, bf16* WT, int kb, int nb, int row_off, LAS float* scr, int lane) {
    const int k0 = 64 * kb, n0 = 32 * nb;
#pragma unroll 8
    for (int i = 0; i < 32; ++i) { const int kk = 2 * i + (lane >> 5); scr[kk * 33 + (lane & 31)] = W[(size_t)(k0 + kk) * N + n0 + (lane & 31)]; }
    LDS_WAIT(); asm volatile("" ::: "memory");
    const int c = lane & 7;
#pragma unroll
    for (int j = 0; j < 4; ++j) { const int n = (lane >> 3) + 8 * j; const LAS float* s = scr + (8 * c) * 33 + n;
        v4u o; o.x = pk2(s[0 * 33], s[1 * 33]); o.y = pk2(s[2 * 33], s[3 * 33]); o.z = pk2(s[4 * 33], s[5 * 33]); o.w = pk2(s[6 * 33], s[7 * 33]);
        *(v4u*)(WT + (size_t)(row_off + n0 + n) * K + k0 + 8 * c) = o; }
    LDS_WAIT(); asm volatile("" ::: "memory");
}
__device__ __forceinline__ void convert_weights(const Args& a, int l, LAS unsigned char* lds, int gw, int NGW, int wave, int lane) {
    LAS float* scr = (LAS float*)(lds + wave * 16384);
    const float* w_in = a.in[7] + (size_t)l * 1024 * PIN; const float* w_out = a.in[24] + (size_t)l * 1024 * 1024;
    const float* w_gu = a.in[26] + (size_t)l * 1024 * 5632; const float* w_dn = a.in[27] + (size_t)l * DFF * 1024;
    bf16* Win = (bf16*)(a.ws + WS_WIN); bf16* Wout = (bf16*)(a.ws + WS_WOUT); bf16* Wgu = (bf16*)(a.ws + WS_WGU); bf16* Wdn = (bf16*)(a.ws + WS_WDN);
    constexpr int I_IN = 16 * 92, I_OUT = 16 * 32, I_GU = 16 * 176, I_DN = 44 * 32, I_PAD = 128;
    constexpr int NIT = I_IN + I_OUT + I_GU + I_DN + I_PAD;
    {
        bf16* LW = (bf16*)(a.ws + WS_LORA); bf16* LA = LW + 65536; bf16* LG = LA + 65536;
        const float* w2 = a.in[15] + (size_t)l * 65536; const float* a2 = a.in[17] + (size_t)l * 65536; const float* g2 = a.in[18] + (size_t)l * 65536;
        for (int e = gw * 64 + lane; e < 65536; e += NGW * 64) { const int col = e & 511, i = (e >> 9) & 63, dir = e >> 15;
            const int dst = ((dir * 8 + (col >> 6)) * 64 + (col & 63)) * 64 + i; LW[dst] = (bf16)f2bf(w2[e]); LA[dst] = (bf16)f2bf(a2[e]); }
        for (int e = gw * 64 + lane; e < 65536; e += NGW * 64) { const int col = e & 511, i = e >> 9;
            LG[((col >> 6) * 64 + (col & 63)) * 128 + i] = (bf16)f2bf(g2[e]); }
    }
    for (int it = gw; it < NIT; it += NGW) {
        int r = it;
        if (r < I_IN) { transpose_item(w_in, 1024, PIN, Win, r / 92, r % 92, 0, scr, lane); continue; } r -= I_IN;
        if (r < I_OUT) { transpose_item(w_out, 1024, 1024, Wout, r / 32, r % 32, 0, scr, lane); continue; } r -= I_OUT;
        if (r < I_GU) { const int kb = r / 176, nb = r % 176; const int n0 = 32 * nb; const int up = n0 >= DFF ? 1 : 0; const int j0 = n0 - up * DFF;
            const int dest = 256 * (j0 >> 7) + 128 * up + (j0 & 127);
            transpose_item(w_gu, 1024, 5632, Wgu, kb, nb, dest - n0, scr, lane); continue; } r -= I_GU;
        if (r < I_DN) { transpose_item(w_dn, DFF, 1024, Wdn, r / 32, r % 32, 0, scr, lane); continue; } r -= I_DN;
        { v4u z = {0u, 0u, 0u, 0u}; v4u* p = (v4u*)(Win + (size_t)(PIN + r) * 1024);
          p[lane] = z; p[lane + 64] = z; }
    }
}

__device__ __forceinline__ void mod_phase(const Args& a, LAS unsigned char* lds, int tid) {
    LAS float* sc = (LAS float*)lds;
    LAS float* part = (LAS float*)(lds + 81920);
    const float* cp = a.in[2]; const float* cs = a.in[3];
    for (int e = tid; e < 20 * 1024; e += NTHR) { const int b = e >> 10, k = e & 1023; float v = 0.f;
        if (b < 17) { const float cv = b < 16 ? cp[b * 1024 + k] : cs[k]; v = cv / (1.f + __expf(-cv)); }
        sc[k * 20 + b] = v; }
    __syncthreads();
    float* mod = (float*)(a.ws + WS_MOD);
    const int col = tid & 63, kg = tid >> 6;
    for (int item = blockIdx.x; item < 4 * 96; item += gridDim.x) {
        const int l = item / 96, n0 = (item % 96) * 64;
        float acc[17];
#pragma unroll
        for (int b = 0; b < 17; ++b) acc[b] = 0.f;
        const float* wp = a.in[4] + ((size_t)l * 1024 + kg * 128) * NMOD + n0 + col;
#pragma unroll 16
        for (int kk = 0; kk < 128; ++kk) { const float w = wp[(size_t)kk * NMOD]; const LAS float* s = sc + (kg * 128 + kk) * 20;
            const f32x4 s0 = *(const LAS f32x4*)(s), s1 = *(const LAS f32x4*)(s + 4), s2 = *(const LAS f32x4*)(s + 8), s3 = *(const LAS f32x4*)(s + 12); const float s4 = s[16];
#pragma unroll
            for (int j = 0; j < 4; ++j) { acc[j] += s0[j] * w; acc[4 + j] += s1[j] * w; acc[8 + j] += s2[j] * w; acc[12 + j] += s3[j] * w; }
            acc[16] += s4 * w; }
#pragma unroll
        for (int b = 0; b < 17; ++b) part[(kg * 17 + b) * 64 + col] = acc[b];
        __syncthreads();
        for (int e = tid; e < 17 * 64; e += NTHR) { const int b = e >> 6, cc = e & 63; float s = 0.f;
#pragma unroll
            for (int g = 0; g < 8; ++g) s += part[(g * 17 + b) * 64 + cc];
            mod[((size_t)l * 17 + b) * NMOD + n0 + cc] = s + a.in[5][l * NMOD + n0 + cc]; }
        __syncthreads();
    }
    { bf16* wsp = (bf16*)(a.ws + WS_WSP); const float* src = a.in[10];
      for (int e = blockIdx.x * NTHR + tid; e < 262144 / 2; e += gridDim.x * NTHR) ((unsigned*)wsp)[e] = pk2(src[2 * e], src[2 * e + 1]); }
}

constexpr int NR = 4;
__device__ __forceinline__ void norm_phase(const float* xa, const float* xb, const float* g, const float* modl, int sh_off, int sc_off, bf16* XN, int gw, int NGW, int lane) {
    for (int row0 = gw; row0 < MTOK; row0 += NR * NGW) {
        f32x4 v[NR][4]; float s[NR];
#pragma unroll
        for (int q = 0; q < NR; ++q) { const int row = row0 + q * NGW; s[q] = 0.f; if (row < MTOK) { const float* xr = row < 32768 ? xa + (size_t)row * 1024 : xb + (size_t)(row - 32768) * 1024;
#pragma unroll
            for (int j = 0; j < 4; ++j) v[q][j] = ((const f32x4*)xr)[lane + 64 * j]; } }
#pragma unroll
        for (int q = 0; q < NR; ++q) if (row0 + q * NGW < MTOK) {
#pragma unroll
            for (int j = 0; j < 4; ++j) s[q] += (v[q][j].x * v[q][j].x + v[q][j].y * v[q][j].y) + (v[q][j].z * v[q][j].z + v[q][j].w * v[q][j].w); }
#pragma unroll
        for (int q = 0; q < NR; ++q) if (row0 + q * NGW < MTOK) { const int row = row0 + q * NGW; const int b = pg8::batch_of_row(row);
            const float rstd = rsqrtf(wave_sum(s[q]) * (1.f / 1024.f) + EPS_F);
            const float* mb = modl + (size_t)b * NMOD;
#pragma unroll
            for (int j = 0; j < 4; ++j) { const int col = 4 * lane + 256 * j;
                const f32x4 gv = *(const f32x4*)(g + col), scv = *(const f32x4*)(mb + sc_off + col), shv = *(const f32x4*)(mb + sh_off + col);
                const f32x4 o = v[q][j] * rstd * gv * (scv + 1.f) + shv;
                v2u w; w.x = pk2(o.x, o.y); w.y = pk2(o.z, o.w); *(v2u*)(XN + (size_t)row * 1024 + col) = w; } }
    }
}
__device__ __forceinline__ void final_norm_phase(float* x, const float* g, int gw, int NGW, int lane) {
    for (int row0 = gw; row0 < MTOK; row0 += NR * NGW) {
        f32x4 v[NR][4]; float s[NR];
#pragma unroll
        for (int q = 0; q < NR; ++q) { s[q] = 0.f; if (row0 + q * NGW < MTOK) { const float* xr = x + (size_t)(row0 + q * NGW) * 1024;
#pragma unroll
            for (int j = 0; j < 4; ++j) v[q][j] = ((const f32x4*)xr)[lane + 64 * j]; } }
#pragma unroll
        for (int q = 0; q < NR; ++q) if (row0 + q * NGW < MTOK) {
#pragma unroll
            for (int j = 0; j < 4; ++j) s[q] += (v[q][j].x * v[q][j].x + v[q][j].y * v[q][j].y) + (v[q][j].z * v[q][j].z + v[q][j].w * v[q][j].w); }
#pragma unroll
        for (int q = 0; q < NR; ++q) if (row0 + q * NGW < MTOK) { float* xr = x + (size_t)(row0 + q * NGW) * 1024; const float rstd = rsqrtf(wave_sum(s[q]) * (1.f / 1024.f) + EPS_F);
#pragma unroll
            for (int j = 0; j < 4; ++j) { const f32x4 gv = *(const f32x4*)(g + 4 * lane + 256 * j); ((f32x4*)xr)[lane + 64 * j] = v[q][j] * rstd * gv; } }
    }
}

__device__ __forceinline__ void mixer_a_item(LAS unsigned char* lds, const Args& a, int l, int item, int tid, int wave, int lane) {
    const bf16* P = (const bf16*)(a.ws + WS_P); bf16* Y = (bf16*)(a.ws + WS_XN); const bf16* wsp = (const bf16*)(a.ws + WS_WSP) + (size_t)l * 65536;
    const float* ln_w = a.in[8] + l * 512; const float* ln_b = a.in[9] + l * 512; const float* b_sp = a.in[11] + l * 512; const float* out_g = a.in[12] + l * 512;
    const int c = item >> 2, h = item & 3, r0 = c * 128;
    LAS bf16* vnT = (LAS bf16*)lds;
    LAS float* ob = (LAS float*)(lds + 34816);
    {
        const float lw0 = ln_w[h * 128 + 2 * lane], lw1 = ln_w[h * 128 + 2 * lane + 1], lb0 = ln_b[h * 128 + 2 * lane], lb1 = ln_b[h * 128 + 2 * lane + 1];
        unsigned wv[16];
#pragma unroll
        for (int qi = 0; qi < 16; ++qi) wv[qi] = *(const unsigned*)(P + (size_t)(r0 + 16 * wave + qi) * PLD + 512 + h * 128 + 2 * lane);
#pragma unroll
        for (int qi = 0; qi < 16; ++qi) { const int q = 16 * wave + qi; const unsigned w = wv[qi];
            const float v0 = gelu_f(bf2f(w & 0xffffu)), v1 = gelu_f(bf2f(w >> 16));
            const float mu = wave_sum(v0 + v1) * (1.f / 128.f); const float d0 = v0 - mu, d1 = v1 - mu;
            const float rstd = rsqrtf(wave_sum(d0 * d0 + d1 * d1) * (1.f / 128.f) + EPS_F);
            vnT[(2 * lane) * 136 + q] = (bf16)f2bf(d0 * rstd * lw0 + lb0); vnT[(2 * lane + 1) * 136 + q] = (bf16)f2bf(d1 * rstd * lw1 + lb1); }
    }
    __syncthreads();
    const int wp = wave >> 1, wd = wave & 1, l31 = lane & 31, hi = lane >> 5;
    f32x16 acc[2];
#pragma unroll
    for (int t = 0; t < 2; ++t)
#pragma unroll
        for (int r = 0; r < 16; ++r) acc[t][r] = 0.f;
#pragma unroll
    for (int ks = 0; ks < 8; ++ks) { const int k0 = 16 * ks;
        const bf16x8 af = *(const bf16x8*)(wsp + (size_t)h * 16384 + (32 * wp + l31) * 128 + k0 + 8 * hi);
#pragma unroll
        for (int t = 0; t < 2; ++t) { const bf16x8 bfr = *(const LAS bf16x8*)(vnT + (64 * wd + 32 * t + l31) * 136 + k0 + 8 * hi);
            acc[t] = __builtin_amdgcn_mfma_f32_32x32x16_bf16(af, bfr, acc[t], 0, 0, 0); } }
#pragma unroll
    for (int t = 0; t < 2; ++t) { const int d = 64 * wd + 32 * t + l31; float uu[16];
#pragma unroll
        for (int r = 0; r < 16; ++r) uu[r] = ldbf(P + (size_t)(r0 + 32 * wp + (r & 3) + 8 * (r >> 2) + 4 * hi) * PLD + h * 128 + d);
#pragma unroll
        for (int r = 0; r < 16; ++r) { const int p = 32 * wp + (r & 3) + 8 * (r >> 2) + 4 * hi;
            ob[p * 132 + d] = gelu_f(uu[r]) * (acc[t][r] + b_sp[h * 128 + p]); } }
    __syncthreads();
    {
        const float g0 = out_g[h * 128 + 2 * lane], g1 = out_g[h * 128 + 2 * lane + 1];
        for (int pi = 0; pi < 16; ++pi) { const int p = 16 * wave + pi; const float o0 = ob[p * 132 + 2 * lane], o1 = ob[p * 132 + 2 * lane + 1];
            const float rstd = rsqrtf(wave_sum(o0 * o0 + o1 * o1) * (1.f / 128.f) + EPS_F);
            *(unsigned*)(Y + (size_t)(r0 + p) * 1024 + h * 128 + 2 * lane) = pk2(o0 * rstd * g0, o1 * rstd * g1); }
    }
    __syncthreads();
}

__device__ __forceinline__ float ts_val(const bf16* P, size_t row, int pos, int len, int j, const float* mu) {
    const bf16* p = P + row * PLD + 1024 + j; const float pc = ldbf(p); const float pp = pos > 0 ? ldbf(p - PLD) : 0.f; const float pn = pos < len - 1 ? ldbf(p + PLD) : 0.f;
    return pc + mu[j] * (pp - pc) + mu[1920 + j] * (pn - pc);
}
constexpr size_t WS_AB = 412 * MiB;
struct ScanLds { LAS bf16 *W2t, *A2t, *G2t, *DWb, *DAb, *DGb, *Kap, *Rt, *Kt, *Bt, *Kh, *Bh, *Vt, *GVb, *Akk, *Akr, *Abr, *S16, *Ub, *U0b, *BQ, *BQT, *BW, *TiT; LAS float *Rs, *KRs, *Vs, *LWs, *LAs, *Ys, *WT, *Wend, *SBs, *MU; };
template <int NV> __device__ __forceinline__ ScanLds scan_lds(LAS unsigned char* lds) {
    ScanLds L; L.W2t = (LAS bf16*)(lds); L.A2t = (LAS bf16*)(lds + 9216); L.G2t = (LAS bf16*)(lds + 18432);
    L.Rs = (LAS float*)(lds + 36864); L.KRs = (LAS float*)(lds + 45056); L.U0b = (LAS bf16*)(lds + 36864); L.Ys = (LAS float*)(lds + 45056);
    L.Vs = (LAS float*)(lds + 53248);
    L.LWs = (LAS float*)(lds + 61440); L.LAs = (LAS float*)(lds + 69632); L.DWb = (LAS bf16*)(lds + 77824); L.DAb = (LAS bf16*)(lds + 82432); L.DGb = (LAS bf16*)(lds + 87040);
    L.S16 = (LAS bf16*)(lds + 61440); L.Ub = (LAS bf16*)(lds + 61440 + NV * 144);
    L.BQ = (LAS bf16*)(lds + 61440 + NV * 224); L.BQT = (LAS bf16*)(lds + 61440 + NV * 224 + 2560);
    if (NV == 64) { L.BW = (LAS bf16*)(lds + 61440 + NV * 224 + 5120); L.TiT = (LAS bf16*)(lds + 61440 + NV * 224 + 7680); }
    else { L.BW = (LAS bf16*)(lds + 36864 + 10240); L.TiT = (LAS bf16*)(lds + 36864 + 12800); }
    L.Kap = (LAS bf16*)(lds + 95744); L.Rt = (LAS bf16*)(lds + 100352); L.Kt = (LAS bf16*)(lds + 104960); L.Bt = (LAS bf16*)(lds + 109568);
    L.Kh = (LAS bf16*)(lds + 114176); L.Bh = (LAS bf16*)(lds + 119296); L.Vt = (LAS bf16*)(lds + 124416); L.GVb = (LAS bf16*)(lds + 124416 + 5120);
    L.WT = (LAS float*)(lds + 134656); L.Wend = (LAS float*)(lds + 136704); L.SBs = (LAS float*)(lds + 136960);
    L.MU = (LAS float*)(lds + 147456);
    L.Akk = (LAS bf16*)(lds + 137088); L.Akr = (LAS bf16*)(lds + 139648); L.Abr = (LAS bf16*)(lds + 142208); return L;
}
__device__ __forceinline__ float fast_sigmoid(float x) { return __builtin_amdgcn_rcpf(1.f + __expf(-x)); }
__device__ __forceinline__ float fast_tanh(float x) { return 1.f - 2.f * __builtin_amdgcn_rcpf(1.f + __expf(2.f * x)); }
struct ScanCh { float kkw, kaw, rkw, w0v, a0v; };
__device__ __forceinline__ f32x4 ts4(const bf16* P, size_t row, int pos, int len, int j, const float* mu) {
    const bf16* p = P + row * PLD + 1024 + j;
    const v2u c = *(const v2u*)p; v2u pv = {0u, 0u}, nv = {0u, 0u};
    if (pos > 0) pv = *(const v2u*)(p - PLD);
    if (pos < len - 1) nv = *(const v2u*)(p + PLD);
    const f32x4 pc = {bf2f(c.x & 0xffffu), bf2f(c.x >> 16), bf2f(c.y & 0xffffu), bf2f(c.y >> 16)};
    const f32x4 pp = {bf2f(pv.x & 0xffffu), bf2f(pv.x >> 16), bf2f(pv.y & 0xffffu), bf2f(pv.y >> 16)};
    const f32x4 pn = {bf2f(nv.x & 0xffffu), bf2f(nv.x >> 16), bf2f(nv.y & 0xffffu), bf2f(nv.y >> 16)};
    const f32x4 m0 = *(const f32x4*)(mu + j), m1 = *(const f32x4*)(mu + 1920 + j);
    return pc + m0 * (pp - pc) + m1 * (pn - pc);
}
struct RawQ { v2u c, p, n; };
__device__ __forceinline__ RawQ ts4_load(const bf16* P, size_t row, int pos, int len, int j) {
    const bf16* p = P + row * PLD + 1024 + j; RawQ q; q.c = *(const v2u*)p; q.p = (v2u){0u, 0u}; q.n = (v2u){0u, 0u};
    if (pos > 0) q.p = *(const v2u*)(p - PLD);
    if (pos < len - 1) q.n = *(const v2u*)(p + PLD);
    return q;
}
__device__ __forceinline__ f32x4 ts4_apply(const RawQ& q, const LAS float* MU, int grp, int col) {
    const f32x4 pc = {bf2f(q.c.x & 0xffffu), bf2f(q.c.x >> 16), bf2f(q.c.y & 0xffffu), bf2f(q.c.y >> 16)};
    const f32x4 pp = {bf2f(q.p.x & 0xffffu), bf2f(q.p.x >> 16), bf2f(q.p.y & 0xffffu), bf2f(q.p.y >> 16)};
    const f32x4 pn = {bf2f(q.n.x & 0xffffu), bf2f(q.n.x >> 16), bf2f(q.n.y & 0xffffu), bf2f(q.n.y >> 16)};
    const f32x4 m0 = *(const LAS f32x4*)(MU + (grp * 2) * 64 + col), m1 = *(const LAS f32x4*)(MU + (grp * 2 + 1) * 64 + col);
    return pc + m0 * (pp - pc) + m1 * (pn - pc);
}
struct Raw { RawQ q[5]; RawQ g[2]; };
template <bool FULL> __device__ __forceinline__ void raw_load(Raw& R, const bf16* P, int s0, int len, int pos0, int h, int dir, bool doG, int tid) {
    const int t = tid >> 4, cq = (tid & 15) * 4; const int pos = pos0 + (dir ? 31 - t : t); const size_t row = (size_t)(s0 + pos);
    if (FULL) R.q[0] = ts4_load(P, row, pos, len, h * 64 + cq);
    R.q[1] = ts4_load(P, row, pos, len, 512 + h * 64 + cq); R.q[2] = ts4_load(P, row, pos, len, 1024 + h * 64 + cq);
    R.q[3] = ts4_load(P, row, pos, len, 1536 + dir * 64 + cq); R.q[4] = ts4_load(P, row, pos, len, 1664 + dir * 64 + cq);
    if (doG) { const int c8 = (tid & 15) * 8; R.g[0] = ts4_load(P, row, pos, len, 1792 + c8); R.g[1] = ts4_load(P, row, pos, len, 1792 + c8 + 4); }
}
__device__ __forceinline__ int mrow(int r, int hi) { return (r & 3) + 8 * (r >> 2) + 4 * hi; }
template <int KS> __device__ __forceinline__ void mm32(f32x16& acc, const LAS bf16* X, int px, int xrow0, const LAS bf16* Y, int py, int yrow0, int l31, int hi) {
#pragma unroll
    for (int ks = 0; ks < KS; ++ks) { const bf16x8 af = *(const LAS bf16x8*)(X + (xrow0 + l31) * px + 16 * ks + 8 * hi); const bf16x8 bfr = *(const LAS bf16x8*)(Y + (yrow0 + l31) * py + 16 * ks + 8 * hi);
        acc = __builtin_amdgcn_mfma_f32_32x32x16_bf16(af, bfr, acc, 0, 0, 0); }
}
template <int NV, bool FULL> __device__ __forceinline__ void scan_prep(const ScanLds& L, Raw& R, const bf16* P, const float* mu, int s0, int len, int pos0_next, bool has_next, int h, int dir, const ScanCh& ch, bool doG, int tid_, int wave, int lane_) {
    int tid = tid_, lane = lane_; asm volatile("" : "+v"(tid), "+v"(lane));
    __syncthreads();
    {
        const int t = tid >> 4, cq = (tid & 15) * 4;
        const LAS float* MU = L.MU;
        if (FULL) *(LAS f32x4*)(L.Rs + t * 64 + cq) = ts4_apply(R.q[0], MU, 0, cq);
        *(LAS f32x4*)(L.KRs + t * 64 + cq) = ts4_apply(R.q[1], MU, 1, cq);
        *(LAS f32x4*)(L.Vs + t * 64 + cq) = ts4_apply(R.q[2], MU, 2, cq);
        const f32x4 dw = ts4_apply(R.q[3], MU, 3, cq), da = ts4_apply(R.q[4], MU, 4, cq);
        v2u w; w.x = pk2(fast_tanh(dw.x), fast_tanh(dw.y)); w.y = pk2(fast_tanh(dw.z), fast_tanh(dw.w)); *(LAS v2u*)(L.DWb + t * 72 + cq) = w;
        v2u x; x.x = pk2(da.x, da.y); x.y = pk2(da.z, da.w); *(LAS v2u*)(L.DAb + t * 72 + cq) = x;
        if (doG) { const int c8 = (tid & 15) * 8; const f32x4 g0 = ts4_apply(R.g[0], MU, 5 + (c8 >> 6), c8 & 63), g1 = ts4_apply(R.g[1], MU, 5 + (c8 >> 6), (c8 & 63) + 4);
            v4u gq; gq.x = pk2(fast_sigmoid(g0.x), fast_sigmoid(g0.y)); gq.y = pk2(fast_sigmoid(g0.z), fast_sigmoid(g0.w)); gq.z = pk2(fast_sigmoid(g1.x), fast_sigmoid(g1.y)); gq.w = pk2(fast_sigmoid(g1.z), fast_sigmoid(g1.w));
            *(LAS v4u*)(L.DGb + t * 136 + c8) = gq; }
        if (has_next) raw_load<FULL>(R, P, s0, len, pos0_next, h, dir, doG, tid);
    }
    __syncthreads();
    const int l15 = lane & 15, lq = lane >> 4, th = wave >> 2, cqw = wave & 3, c = 16 * cqw + l15, tg = 4 * th + lq, t0 = 4 * tg;
    LAS float* PK = L.LWs; LAS float* PSB = L.LWs + 128;
    f32x4 alw = {0.f, 0.f, 0.f, 0.f}, ala = {0.f, 0.f, 0.f, 0.f};
#pragma unroll
    for (int ks = 0; ks < 2; ++ks) {
        const bf16x8 aw = *(const LAS bf16x8*)(L.DWb + (16 * th + l15) * 72 + 32 * ks + 8 * lq), bw = *(const LAS bf16x8*)(L.W2t + c * 72 + 32 * ks + 8 * lq);
        const bf16x8 aa = *(const LAS bf16x8*)(L.DAb + (16 * th + l15) * 72 + 32 * ks + 8 * lq), ba = *(const LAS bf16x8*)(L.A2t + c * 72 + 32 * ks + 8 * lq);
        alw = __builtin_amdgcn_mfma_f32_16x16x32_bf16(aw, bw, alw, 0, 0, 0); ala = __builtin_amdgcn_mfma_f32_16x16x32_bf16(aa, ba, ala, 0, 0, 0); }
    if (doG) { f32x4 ag = {0.f, 0.f, 0.f, 0.f};
#pragma unroll
        for (int ks = 0; ks < 4; ++ks) { const bf16x8 ga = *(const LAS bf16x8*)(L.DGb + (16 * th + l15) * 136 + 32 * ks + 8 * lq), gb = *(const LAS bf16x8*)(L.G2t + c * 136 + 32 * ks + 8 * lq);
            ag = __builtin_amdgcn_mfma_f32_16x16x32_bf16(ga, gb, ag, 0, 0, 0); }
#pragma unroll
        for (int r = 0; r < 4; ++r) L.GVb[(t0 + r) * 64 + c] = (bf16)f2bf(ag[r]); }
    float ld[4], kkr[4], av4[4], kd[4], rr[4], vv[4];
#pragma unroll
    for (int r = 0; r < 4; ++r) { const int t = t0 + r;
        ld[r] = -0.60653065971f * fast_sigmoid(alw[r] + ch.w0v);
        av4[r] = fast_sigmoid(ala[r] + ch.a0v);
        const float kraw = L.KRs[t * 64 + c]; kkr[r] = kraw * ch.kkw; kd[r] = kraw * (1.f + (av4[r] - 1.f) * ch.kaw);
        rr[r] = FULL ? L.Rs[t * 64 + c] : 0.f; vv[r] = L.Vs[t * 64 + c];
        const float pk = red16(kkr[r] * kkr[r]); if (l15 == 0) PK[t * 4 + cqw] = pk;
        if (FULL) { const float ps = red16(rr[r] * kd[r] * ch.rkw); if (l15 == 0) PSB[t * 4 + cqw] = ps; } }
    float pl[4]; pl[0] = ld[0]; pl[1] = pl[0] + ld[1]; pl[2] = pl[1] + ld[2]; pl[3] = pl[2] + ld[3];
    L.WT[tg * 64 + c] = pl[3];
    __syncthreads();
    float off = 0.f, tot = 0.f;
#pragma unroll
    for (int w = 0; w < 8; ++w) { const float x = L.WT[w * 64 + c]; tot += x; if (w < tg) off += x; }
    const float etot = __expf(tot);
    if (tg == 0) L.Wend[c] = etot;
    float khv[4], bhv[4]; float e_last = __expf(off);
#pragma unroll
    for (int r = 0; r < 4; ++r) { const int t = t0 + r; const float Lc = off + pl[r];
        const f32x4 p4 = *(const LAS f32x4*)(PK + t * 4); const float kk = kkr[r] * rsqrtf(fmaxf((p4.x + p4.y) + (p4.z + p4.w), 1e-24f)); const float bd = kk * av4[r];
        if (FULL && cqw == 0 && l15 == 0) { const f32x4 s4 = *(const LAS f32x4*)(PSB + t * 4); L.SBs[t] = (s4.x + s4.y) + (s4.z + s4.w); }
        const float e_in = __expf(Lc), e_prev = e_last, e_inv = __builtin_amdgcn_rcpf(e_in), e_end = etot * e_inv; e_last = e_in;
        L.Kap[t * 72 + c] = (bf16)f2bf(kk * e_prev); if (FULL) L.Rt[t * 72 + c] = (bf16)f2bf(rr[r] * e_in);
        L.Kt[t * 72 + c] = (bf16)f2bf(kd[r] * e_inv); L.Bt[t * 72 + c] = (bf16)f2bf(bd * e_inv);
        khv[r] = kd[r] * e_end; bhv[r] = -bd * e_end; }
    { v2u w; w.x = pk2(khv[0], khv[1]); w.y = pk2(khv[2], khv[3]); *(LAS v2u*)(L.Kh + c * 40 + t0) = w;
      v2u x; x.x = pk2(bhv[0], bhv[1]); x.y = pk2(bhv[2], bhv[3]); *(LAS v2u*)(L.Bh + c * 40 + t0) = x;
      v2u y; y.x = pk2(vv[0], vv[1]); y.y = pk2(vv[2], vv[3]); *(LAS v2u*)(L.Vt + c * 40 + t0) = y; }
    __syncthreads();
}
__device__ __forceinline__ void nat_store(LAS bf16* buf, const f32x16& d, int l31, int hi) {
#pragma unroll
    for (int g = 0; g < 4; ++g) { v2u w; w.x = pk2(d[4 * g], d[4 * g + 1]); w.y = pk2(d[4 * g + 2], d[4 * g + 3]); *(LAS v2u*)(buf + l31 * 40 + 8 * g + 4 * hi) = w; }
}
template <int NV, bool WITHY> __device__ __forceinline__ void scan_chunk(const ScanLds& L, f32x16& st, bool hasT, int kt, int vt, int wave, int lane_, bf16* ypark = nullptr) {
    int lane = lane_; asm volatile("" : "+v"(lane));
    const int l31 = lane & 31, hi = lane >> 5;
    const int utile = (wave >= 1 && wave <= NV / 32) ? wave - 1 : -1;
    f32x16 Q, QT, W;
    if (hasT) {
#pragma unroll
        for (int g = 0; g < 4; ++g) { v2u w; w.x = pk2(st[4 * g], st[4 * g + 1]); w.y = pk2(st[4 * g + 2], st[4 * g + 3]); *(LAS v2u*)(L.S16 + (32 * vt + l31) * 72 + 32 * kt + 8 * g + 4 * hi) = w; }
    }
    if (wave == 0) {
#pragma unroll
        for (int r = 0; r < 16; ++r) { Q[r] = 0.f; QT[r] = 0.f; }
        mm32<4>(Q, L.Bt, 72, 0, L.Kap, 72, 0, l31, hi);
        mm32<4>(QT, L.Kap, 72, 0, L.Bt, 72, 0, l31, hi);
#pragma unroll
        for (int r = 0; r < 16; ++r) { const int row = mrow(r, hi); Q[r] = row < l31 ? Q[r] : 0.f; QT[r] = l31 < row ? QT[r] : 0.f; W[r] = (row == l31 ? 1.f : 0.f) - QT[r]; }
        nat_store(L.BQ, Q, l31, hi); nat_store(L.BQT, QT, l31, hi);
        {   f32x16 Qn, QTn;
#pragma unroll
            for (int r = 0; r < 16; ++r) { Qn[r] = 0.f; QTn[r] = 0.f; }
            mm32<2>(Qn, L.BQT, 40, 0, L.BQ, 40, 0, l31, hi); mm32<2>(QTn, L.BQ, 40, 0, L.BQT, 40, 0, l31, hi); Q = Qn; QT = QTn; }
#pragma unroll
        for (int n = 1; n < 3; ++n) {
            nat_store(L.BQ, Q, l31, hi); nat_store(L.BQT, QT, l31, hi); nat_store(L.BW, W, l31, hi);
            f32x16 Qn, QTn;
#pragma unroll
            for (int r = 0; r < 16; ++r) { Qn[r] = 0.f; QTn[r] = 0.f; }
            mm32<2>(W, L.BQ, 40, 0, L.BW, 40, 0, l31, hi); mm32<2>(Qn, L.BQT, 40, 0, L.BQ, 40, 0, l31, hi); mm32<2>(QTn, L.BQ, 40, 0, L.BQT, 40, 0, l31, hi); Q = Qn; QT = QTn; }
    } else if (wave == 1) {
        f32x16 acc;
#pragma unroll
        for (int r = 0; r < 16; ++r) acc[r] = 0.f;
        mm32<4>(acc, L.Kt, 72, 0, L.Kap, 72, 0, l31, hi);
#pragma unroll
        for (int r = 0; r < 16; ++r) acc[r] = mrow(r, hi) < l31 ? acc[r] : 0.f;
        nat_store(L.Akk, acc, l31, hi);
    } else if (WITHY && (wave == 2 || wave == 3)) {
        f32x16 acc;
#pragma unroll
        for (int r = 0; r < 16; ++r) acc[r] = 0.f;
        mm32<4>(acc, wave == 2 ? L.Kt : L.Bt, 72, 0, L.Rt, 72, 0, l31, hi);
        const float sg = wave == 3 ? -1.f : 1.f;
#pragma unroll
        for (int r = 0; r < 16; ++r) acc[r] = mrow(r, hi) <= l31 ? sg * acc[r] : 0.f;
        nat_store(wave == 2 ? L.Akr : L.Abr, acc, l31, hi);
    }
    __syncthreads();
    f32x16 accy;
#pragma unroll
    for (int r = 0; r < 16; ++r) accy[r] = 0.f;
    if (utile >= 0) {
        f32x16 acc;
#pragma unroll
        for (int r = 0; r < 16; ++r) acc[r] = 0.f;
        mm32<4>(acc, L.Kap, 72, 0, L.S16, 72, 32 * utile, l31, hi);
        if (utile < 2) mm32<2>(acc, L.Akk, 40, 0, L.Vt, 40, 32 * utile, l31, hi);
        nat_store(L.U0b + 32 * utile * 40, acc, l31, hi);
        if (WITHY) { mm32<4>(accy, L.Rt, 72, 0, L.S16, 72, 32 * utile, l31, hi); mm32<2>(accy, L.Akr, 40, 0, L.Vt, 40, 32 * utile, l31, hi); }
    }
    if (wave == 0) {
#pragma unroll
        for (int n = 3; n < 5; ++n) {
            nat_store(L.BQ, Q, l31, hi); if (n < 4) nat_store(L.BQT, QT, l31, hi); nat_store(L.BW, W, l31, hi);
            f32x16 Qn, QTn;
#pragma unroll
            for (int r = 0; r < 16; ++r) { Qn[r] = 0.f; QTn[r] = 0.f; }
            mm32<2>(W, L.BQ, 40, 0, L.BW, 40, 0, l31, hi);
            if (n < 4) { mm32<2>(Qn, L.BQT, 40, 0, L.BQ, 40, 0, l31, hi); mm32<2>(QTn, L.BQ, 40, 0, L.BQT, 40, 0, l31, hi); Q = Qn; QT = QTn; } }
#pragma unroll
        for (int r = 0; r < 16; ++r) L.TiT[mrow(r, hi) * 40 + l31] = (bf16)f2bf(W[r]);
    }
    if (hasT) {
#pragma unroll
        for (int r = 0; r < 16; ++r) st[r] *= L.Wend[32 * kt + mrow(r, hi)];
        if (vt < 2) mm32<2>(st, L.Kh, 40, 32 * kt, L.Vt, 40, 32 * vt, l31, hi);
    }
    __syncthreads();
    if (utile >= 0) {
        f32x16 acc;
#pragma unroll
        for (int r = 0; r < 16; ++r) acc[r] = 0.f;
        mm32<2>(acc, L.TiT, 40, 0, L.U0b, 40, 32 * utile, l31, hi);
        nat_store(L.Ub + 32 * utile * 40, acc, l31, hi);
    }
    __syncthreads();
    if (WITHY && utile >= 0) {
        mm32<2>(accy, L.Abr, 40, 0, L.Ub, 40, 32 * utile, l31, hi);
        if (ypark) {
#pragma unroll
            for (int r = 0; r < 16; ++r) ypark[(size_t)mrow(r, hi) * 1024 + 32 * utile + l31] = (bf16)f2bf(accy[r]);
        } else {
#pragma unroll
            for (int r = 0; r < 16; ++r) L.Ys[mrow(r, hi) * 64 + 32 * utile + l31] = accy[r];
        }
    }
    if (hasT) mm32<2>(st, L.Bh, 40, 32 * kt, L.Ub, 40, 32 * vt, l31, hi);
}
__device__ __forceinline__ void scan_load_lora(const ScanLds& L, const Args& a, int l, int dir, int h, int tid) {
    __syncthreads();
    const bf16* LW = (const bf16*)(a.ws + WS_LORA) + (size_t)(dir * 8 + h) * 4096; const bf16* LA = LW + 65536;
    const int c = tid >> 3, part = (tid & 7) * 8;
    *(LAS v4u*)(L.W2t + c * 72 + part) = *(const v4u*)(LW + c * 64 + part); *(LAS v4u*)(L.A2t + c * 72 + part) = *(const v4u*)(LA + c * 64 + part);
    const float* mu = a.in[13] + (size_t)l * 2 * 1920;
    for (int e = tid; e < 896; e += NTHR) { const int grp = e >> 7, which = (e >> 6) & 1, col = e & 63;
        const int jb = grp == 0 ? h * 64 : grp == 1 ? 512 + h * 64 : grp == 2 ? 1024 + h * 64 : grp == 3 ? 1536 + dir * 64 : grp == 4 ? 1664 + dir * 64 : 1792 + (grp - 5) * 64;
        L.MU[e] = mu[which * 1920 + jb + col]; }
}
__device__ __forceinline__ void scan_load_g2(const ScanLds& L, const Args& a, int h, int tid) {
    const bf16* LG = (const bf16*)(a.ws + WS_LORA) + 131072 + (size_t)h * 8192;
#pragma unroll
    for (int q = 0; q < 2; ++q) { const int e = tid + q * NTHR; const int c = e >> 4, part = (e & 15) * 8; *(LAS v4u*)(L.G2t + c * 136 + part) = *(const v4u*)(LG + c * 128 + part); }
}
__device__ __forceinline__ ScanCh scan_ch(const Args& a, int l, int dir, int hc) {
    ScanCh c; c.kkw = a.in[19][l * 512 + hc]; c.kaw = a.in[20][l * 512 + hc]; c.rkw = a.in[21][l * 512 + hc]; c.w0v = a.in[14][(l * 2 + dir) * 512 + hc]; c.a0v = a.in[16][(l * 2 + dir) * 512 + hc]; return c;
}
__device__ __forceinline__ int seg_len(int b) { return b == 16 ? 512 : 1024; }
__device__ __forceinline__ int scan_item_of(int b, int h, int dir, int s) { const int hd = h * 2 + dir; return b == 16 ? hd * 32 + s : 512 + (b * 16 + hd) * 2 + s; }

template <int NV> __device__ __forceinline__ void scan_pass1(LAS unsigned char* lds, const Args& a, int l, int it, int tid, int wave, int lane) {
    int b, h, dir, s;
    if (NV == 64) { b = it >> 4; const int hd = it & 15; h = hd >> 1; dir = hd & 1; s = 0; }
    else { const int j = it - 256; const int hd = j / 31; s = j - hd * 31; b = 16; h = hd >> 1; dir = hd & 1; }
    const int s0 = b < 16 ? b * 2048 : 32768, len = b < 16 ? 2048 : 16384, SEGL = NV == 64 ? 1024 : 512;
    const bf16* P = (const bf16*)(a.ws + WS_P); const float* mu = a.in[13] + (size_t)l * 2 * 1920;
    const ScanLds L = scan_lds<NV>(lds); const ScanCh ch = scan_ch(a, l, dir, h * 64 + 16 * (wave & 3) + (lane & 15));
    Raw R; raw_load<false>(R, P, s0, len, dir ? len - 32 - s * SEGL : s * SEGL, h, dir, false, tid);
    scan_load_lora(L, a, l, dir, h, tid);
    if (NV == 128) { for (int e = tid; e < 64 * 20; e += NTHR) ((LAS unsigned*)(L.Vt + 64 * 40))[e] = 0u; }
    const int l31 = lane & 31, hi = lane >> 5, kt = wave & 1, vt = NV == 128 ? (wave >> 1) : ((wave >> 1) & 1); const bool hasT = NV == 128 ? true : wave >= 4;
    f32x16 st;
#pragma unroll
    for (int r = 0; r < 16; ++r) st[r] = (NV == 128 && (32 * vt + l31 - 64 == 32 * kt + mrow(r, hi))) ? 1.f : 0.f;
    for (int bt = 0; bt < SEGL / 32; ++bt) {
        const int n1 = s * SEGL + 32 * (bt + 1); const int pos1 = dir ? len - 32 - n1 : n1;
        scan_prep<NV, false>(L, R, P, mu, s0, len, pos1, bt + 1 < SEGL / 32, h, dir, ch, false, tid, wave, lane);
        scan_chunk<NV, false>(L, st, hasT, kt, vt, wave, lane);
    }
    float* AB = (float*)(a.ws + WS_AB) + (size_t)scan_item_of(b, h, dir, s) * 8192;
    if (hasT) { const int v = 32 * vt + l31; float* dst = v >= 64 ? AB + (v - 64) * 64 : AB + 4096 + v * 64;
#pragma unroll
      for (int g = 0; g < 4; ++g) *(f32x4*)(dst + 32 * kt + 8 * g + 4 * hi) = (f32x4){st[4 * g], st[4 * g + 1], st[4 * g + 2], st[4 * g + 3]}; }
    __syncthreads();
}
__device__ __forceinline__ void scan_pass2(LAS unsigned char* lds, const Args& a, int id, int tid) {
    int b, hd; if (id < 16) { b = 16; hd = id; } else { b = (id - 16) >> 4; hd = (id - 16) & 15; }
    const int v = tid >> 3, kq = (tid & 7) * 8;
    if (b < 16) {
        float* AB = (float*)(a.ws + WS_AB) + (size_t)(512 + (b * 16 + hd) * 2) * 8192;
        const f32x4 c0 = *(const f32x4*)(AB + 4096 + v * 64 + kq), c1 = *(const f32x4*)(AB + 4096 + v * 64 + kq + 4);
        *(f32x4*)(AB + 8192 + 4096 + v * 64 + kq) = c0; *(f32x4*)(AB + 8192 + 4096 + v * 64 + kq + 4) = c1;
        *(f32x4*)(AB + 4096 + v * 64 + kq) = (f32x4){0.f, 0.f, 0.f, 0.f}; *(f32x4*)(AB + 4096 + v * 64 + kq + 4) = (f32x4){0.f, 0.f, 0.f, 0.f};
        return;
    }
    const int nseg = 32; const int it0 = hd * 32;
    LAS float* Sm = (LAS float*)lds;
    LAS float* Am = (LAS float*)(lds + 32768);
    const int wave = tid >> 6, lane = tid & 63, l31 = lane & 31, hi = lane >> 5, vtl = (wave >> 1) & 1, ktl = wave & 1;
    __syncthreads();
    for (int e = tid; e < 64 * 65; e += NTHR) Sm[e] = 0.f;
    for (int s = 0; s < nseg; ++s) {
        float* AB = (float*)(a.ws + WS_AB) + (size_t)(it0 + s) * 8192;
        __syncthreads();
        if (s == nseg - 1) { *(f32x4*)(AB + 4096 + v * 64 + kq) = (f32x4){Sm[v * 65 + kq], Sm[v * 65 + kq + 1], Sm[v * 65 + kq + 2], Sm[v * 65 + kq + 3]};
                             *(f32x4*)(AB + 4096 + v * 64 + kq + 4) = (f32x4){Sm[v * 65 + kq + 4], Sm[v * 65 + kq + 5], Sm[v * 65 + kq + 6], Sm[v * 65 + kq + 7]}; break; }
        { const f32x4 a0 = *(const f32x4*)(AB + tid * 8), a1 = *(const f32x4*)(AB + tid * 8 + 4); *(LAS f32x4*)(Am + tid * 8) = a0; *(LAS f32x4*)(Am + tid * 8 + 4) = a1; }
        f32x16 acc;
        if (wave < 4) {
#pragma unroll
            for (int r = 0; r < 16; ++r) acc[r] = AB[4096 + (32 * vtl + mrow(r, hi)) * 64 + 32 * ktl + l31];
        }
        __syncthreads();
        *(f32x4*)(AB + 4096 + v * 64 + kq) = (f32x4){Sm[v * 65 + kq], Sm[v * 65 + kq + 1], Sm[v * 65 + kq + 2], Sm[v * 65 + kq + 3]};
        *(f32x4*)(AB + 4096 + v * 64 + kq + 4) = (f32x4){Sm[v * 65 + kq + 4], Sm[v * 65 + kq + 5], Sm[v * 65 + kq + 6], Sm[v * 65 + kq + 7]};
        if (wave < 4) {
#pragma unroll 8
            for (int ks = 0; ks < 32; ++ks) acc = __builtin_amdgcn_mfma_f32_32x32x2f32(Sm[(32 * vtl + l31) * 65 + 2 * ks + hi], Am[(2 * ks + hi) * 64 + 32 * ktl + l31], acc, 0, 0, 0);
        }
        __syncthreads();
        if (wave < 4) {
#pragma unroll
            for (int r = 0; r < 16; ++r) Sm[(32 * vtl + mrow(r, hi)) * 65 + 32 * ktl + l31] = acc[r];
        }
    }
    __syncthreads();
}
__device__ __forceinline__ void scan_pass3(LAS unsigned char* lds, const Args& a, int l, int it, int tid, int wave, int lane) {
    int b, h, ts; if (it < 256) { ts = it & 1; h = (it >> 1) & 7; b = it >> 4; } else { const int j = it - 256; b = 16; ts = j & 31; h = j >> 5; }
    const int s0 = b < 16 ? b * 2048 : 32768, len = b < 16 ? 2048 : 16384, SEG = seg_len(b), nseg = len / SEG;
    const bf16* P = (const bf16*)(a.ws + WS_P); bf16* Y = (bf16*)(a.ws + WS_XN); const float* mu = a.in[13] + (size_t)l * 2 * 1920;
    const ScanLds L = scan_lds<64>(lds);
    const int hc = h * 64 + lane;
    const float lxw = a.in[22][l * 512 + hc], lxb = a.in[23][l * 512 + hc];
    __syncthreads();
    scan_load_g2(L, a, h, tid);
    const int l31 = lane & 31, hi = lane >> 5, kt = wave & 1, vt = (wave >> 1) & 1; const bool hasT = wave >= 4;
    float* SB0 = (float*)(a.ws + WS_SB);
    for (int dir = 0; dir < 2; ++dir) {
        const ScanCh ch = scan_ch(a, l, dir, h * 64 + 16 * (wave & 3) + (lane & 15));
        const int s = dir ? nseg - 1 - ts : ts;
        Raw R; raw_load<true>(R, P, s0, len, dir ? len - 32 - s * SEG : s * SEG, h, dir, dir == 1, tid);
        scan_load_lora(L, a, l, dir, h, tid);
        const float* Sst = (const float*)(a.ws + WS_AB) + (size_t)scan_item_of(b, h, dir, s) * 8192 + 4096;
        f32x16 st;
#pragma unroll
        for (int g = 0; g < 4; ++g) { const f32x4 x = *(const f32x4*)(Sst + (32 * vt + l31) * 64 + 32 * kt + 8 * g + 4 * hi); st[4 * g] = x.x; st[4 * g + 1] = x.y; st[4 * g + 2] = x.z; st[4 * g + 3] = x.w; }
        for (int bt = 0; bt < SEG / 32; ++bt) {
            const int n0 = s * SEG + 32 * bt; const int pos0 = dir ? len - 32 - n0 : n0;
            const int n1 = n0 + 32; const int pos1 = dir ? len - 32 - n1 : n1;
            scan_prep<64, true>(L, R, P, mu, s0, len, pos1, bt + 1 < SEG / 32, h, dir, ch, dir == 1, tid, wave, lane);
            if (dir == 0) {
                scan_chunk<64, true>(L, st, hasT, kt, vt, wave, lane, Y + (size_t)(s0 + pos0) * 1024 + 512 + h * 64);
                if (tid < 32) SB0[(size_t)(s0 + pos0 + tid) * 8 + h] = L.SBs[tid];
            } else {
                float ypk[4], sbp[4];
#pragma unroll
                for (int tt = 0; tt < 4; ++tt) { const size_t row = (size_t)(s0 + pos0 + 31 - (wave * 4 + tt)); ypk[tt] = ldbf(Y + row * 1024 + 512 + hc); sbp[tt] = SB0[row * 8 + h]; }
                scan_chunk<64, true>(L, st, hasT, kt, vt, wave, lane);
                __syncthreads();
#pragma unroll
                for (int tt = 0; tt < 4; ++tt) { const int t = wave * 4 + tt; const size_t row = (size_t)(s0 + pos0 + 31 - t);
                    const float y = L.Ys[t * 64 + lane] + ypk[tt];
                    const float m = wave_sum(y) * (1.f / 64.f); const float d = y - m; const float var = wave_sum(d * d) * (1.f / 64.f);
                    const float yn = d * rsqrtf(var + GN_EPS_F) * lxw + lxb;
                    const float bonus = (L.SBs[t] + sbp[tt]) * L.Vs[t * 64 + lane];
                    Y[row * 1024 + 512 + hc] = (bf16)f2bf((yn + bonus) * bf2f((unsigned)L.GVb[t * 64 + lane])); }
            }
        }
        __threadfence();
    }
    __syncthreads();
}

#define XB_TMO      128
#define XB_XCNT(j)  (256  + 64 * (j))
#define XB_XSUB(j)  (1280 + 64 * (j))
#define XB_XGEN(j)  (2304 + 64 * (j))
#define XB_TOP      3328
#define XB_TOPGEN   3392
#define XCD_BAR_WORDS 3456
#define XB_SPIN_CAP (1u << 22)

__device__ __forceinline__ unsigned xb_ld(unsigned* p)              { return __hip_atomic_load(p, __ATOMIC_RELAXED, __HIP_MEMORY_SCOPE_AGENT); }
__device__ __forceinline__ unsigned xb_add(unsigned* p, unsigned v) { return __hip_atomic_fetch_add(p, v, __ATOMIC_RELAXED, __HIP_MEMORY_SCOPE_AGENT); }
__device__ __forceinline__ unsigned xb_xcc_id() { return (unsigned)__builtin_amdgcn_s_getreg((3 << 11) | 20) & 0xFu; }
#define XB_SPIN(cond, bar) do { unsigned _sp = 0; while (cond) { __builtin_amdgcn_s_sleep(1); \
    if ((++_sp & 255u) == 0u) { if (xb_ld(&(bar)[XB_TMO])) break; if (_sp > XB_SPIN_CAP) { atomicAdd(&(bar)[XB_TMO], 1u); break; } } } } while (0)

struct XcdBarrier {
    unsigned* bar; unsigned x;
    volatile LAS unsigned* st;
};

__device__ __forceinline__ XcdBarrier xcd_barrier_post(unsigned* bar, volatile LAS unsigned* st) {
    XcdBarrier b; b.bar = bar; b.x = xb_xcc_id(); b.st = st;
    if (threadIdx.x == 0) (void)xb_add(&bar[XB_XCNT(b.x)], 1u);
    return b;
}
__device__ __forceinline__ void xcd_barrier_complete(unsigned* bar, unsigned x, unsigned& nloc, unsigned& nx) {
    const unsigned G = gridDim.x * gridDim.y * gridDim.z;
    unsigned sum, cnt, mine, sp = 0u;
    for (;;) {
        sum = 0u; cnt = 0u; mine = 0u;
#pragma unroll
        for (unsigned j = 0; j < 16; ++j) { const unsigned c = xb_ld(&bar[XB_XCNT(j)]); sum += c; cnt += (c > 0u) ? 1u : 0u; mine = (j == x) ? c : mine; }
        if (sum == G) break;
        __builtin_amdgcn_s_sleep(1);
        if ((++sp & 255u) == 0u) { if (xb_ld(&bar[XB_TMO])) break; if (sp > XB_SPIN_CAP) { atomicAdd(&bar[XB_TMO], 1u); break; } }
    }
    nloc = mine > 0u ? mine : 1u; nx = cnt > 0u ? cnt : 1u;
}

__device__ __forceinline__ void xcd_barrier(const XcdBarrier& b) {
    asm volatile("s_waitcnt vmcnt(0)" ::: "memory");
    __syncthreads();
    if (threadIdx.x == 0) {
        unsigned* bar = b.bar;
        __builtin_amdgcn_s_waitcnt(0);
        unsigned nloc = b.st[0], nx = b.st[1];
        if (nloc == 0u) { xcd_barrier_complete(bar, b.x, nloc, nx); b.st[0] = nloc; b.st[1] = nx; }
        const unsigned old = xb_add(&bar[XB_XSUB(b.x)], 1u);
        const unsigned gen = old / nloc;
        if (old + 1u == (gen + 1u) * nloc) {
            __builtin_amdgcn_fence(__ATOMIC_RELEASE, "agent");
            asm volatile("s_waitcnt vmcnt(0)" ::: "memory");
            const unsigned og = xb_add(&bar[XB_TOP], 1u);
            const unsigned tg = og / nx;
            if (og + 1u == (tg + 1u) * nx) xb_add(&bar[XB_TOPGEN], 1u);
            else XB_SPIN(xb_ld(&bar[XB_TOPGEN]) == tg, bar);
            __builtin_amdgcn_fence(__ATOMIC_ACQUIRE, "agent");
            xb_add(&bar[XB_XGEN(b.x)], 1u);
            asm volatile("s_waitcnt vmcnt(0)" ::: "memory");
        } else {
            XB_SPIN(xb_ld(&bar[XB_XGEN(b.x)]) == gen, bar);
            __builtin_amdgcn_fence(__ATOMIC_ACQUIRE, "agent");
            asm volatile("s_waitcnt vmcnt(0)" ::: "memory");
        }
    }
    __syncthreads();
}

#ifndef G1_ON
#define G1_ON 1
#endif
#ifndef G2_ON
#define G2_ON 1
#endif
#ifndef G3_ON
#define G3_ON 1
#endif
#ifndef G4_ON
#define G4_ON 1
#endif
#if defined(__HIP_DEVICE_COMPILE__)
#define LOAD_ARGS() const __attribute__((address_space(4))) unsigned char* kp_ = (const __attribute__((address_space(4))) unsigned char*)__builtin_amdgcn_kernarg_segment_ptr(); asm volatile("" : "+s"(kp_)); const Args a = *(const __attribute__((address_space(4))) Args*)kp_
#else
#define LOAD_ARGS() const Args a = a0
#endif
template <bool COOP>
__global__ void __launch_bounds__(NTHR, 2) fwd_kernel(Args a0) {
    extern __shared__ __attribute__((aligned(16))) unsigned char lds_raw[];
    LAS unsigned char* lds = (LAS unsigned char*)lds_raw;
    const int G = gridDim.x, NGW = G * NWAVES;
    const int wave0 = __builtin_amdgcn_readfirstlane((int)threadIdx.x >> 6);
#define TIDS() int lane_ = (int)__builtin_amdgcn_mbcnt_hi(~0u, __builtin_amdgcn_mbcnt_lo(~0u, 0u)); asm volatile("" : "+v"(lane_)); const int lane = lane_, wave = wave0, tid = wave0 * 64 + lane, gw = blockIdx.x * NWAVES + wave; (void)gw; (void)lane; (void)tid; LOAD_ARGS()
    cg::grid_group grid = cg::this_grid();
    const int ph_lo = a0.ph_lo, ph_hi = a0.ph_hi;
#define RUN(k) (ph_lo <= (k) && (k) < ph_hi)
    XcdBarrier xbar; xbar.bar = (unsigned*)a0.ws; xbar.x = 0; xbar.st = (volatile LAS unsigned*)(lds + 147392);
    if (COOP) { if (threadIdx.x == 0) { xbar.st[0] = 0u; xbar.st[1] = 0u; } __syncthreads(); xbar = xcd_barrier_post((unsigned*)a0.ws, (volatile LAS unsigned*)(lds + 147392)); }
#define SEAM(k) do { if (COOP) { if (RUN(k) && RUN((k) + 1)) { if ((k) == 0) grid.sync(); else xcd_barrier(xbar); } } } while (0)
#define P_X (a.out)
#define P_XN ((bf16*)(a.ws + WS_XN))
#define P_PB ((bf16*)(a.ws + WS_P))
#define P_MODL ((const float*)(a.ws + WS_MOD) + (size_t)l * 17 * NMOD)
#define P_XA (l == 0 ? a.in[0] : (const float*)a.out)
#define P_XB (l == 0 ? a.in[1] : (const float*)a.out + (size_t)32768 * 1024)
    if (RUN(0)) { TIDS(); mod_phase(a, lds, tid); }
    SEAM(0);
#pragma unroll 1
    for (int l = 0; l < NLAYER; ++l) {
        const int pb = 1 + 9 * l;
        if (RUN(pb + 0)) { TIDS(); convert_weights(a, l, lds, gw, NGW, wave, lane); norm_phase(P_XA, P_XB, a.in[6] + l * 1024, P_MODL, 0, 1024, P_XN, gw, NGW, lane); }
        SEAM(pb + 0);
        if (RUN(pb + 1)) { TIDS(); pg8::Gemm g{P_XN, (const bf16*)(a.ws + WS_WIN), MTOK, PLD, 1024}; pg8::StaticOrder S; S.init(MTOK, PLD, G, (int)blockIdx.x);
            pg8::EpiBf16 E{P_PB, PLD}; pg8::gemm_phase<pg8::EpiBf16, pg8::StaticOrder, true, true>(lds, g, S, E, tid); }
        SEAM(pb + 1);
        if (RUN(pb + 2)) { TIDS(); for (int it = blockIdx.x; it < 752; it += G) { if (it < 256) scan_pass1<64>(lds, a, l, it, tid, wave, lane); else scan_pass1<128>(lds, a, l, it, tid, wave, lane); } }
        SEAM(pb + 2);
        if (RUN(pb + 3)) { TIDS(); for (int id = 16 + blockIdx.x; id < 272; id += G) scan_pass2(lds, a, id, tid);
            if (G > 32) { if (blockIdx.x < 16) scan_pass2(lds, a, (int)blockIdx.x, tid); else for (int it = blockIdx.x - 16; it < 1536; it += G - 16) mixer_a_item(lds, a, l, it, tid, wave, lane); }
            else { for (int it = blockIdx.x; it < 16 + 1536; it += G) { if (it < 16) scan_pass2(lds, a, it, tid); else mixer_a_item(lds, a, l, it - 16, tid, wave, lane); } } }
        SEAM(pb + 3);
        if (RUN(pb + 4)) { TIDS(); for (int it0 = blockIdx.x; it0 < 512; it0 += G) { int it = it0;
            if (G == 256 && it0 < 256) { const int xcd = it0 & 7, slot = it0 >> 3, hh = slot & 7, grp = xcd + 8 * (slot >> 3); it = (grp >> 1) * 16 + hh * 2 + (grp & 1); }
            scan_pass3(lds, a, l, it, tid, wave, lane); } }
        SEAM(pb + 4);
        if (RUN(pb + 5)) { TIDS(); pg8::Gemm g{P_XN, (const bf16*)(a.ws + WS_WOUT), MTOK, 1024, 1024}; pg8::StaticOrder S; S.init(MTOK, 1024, G, (int)blockIdx.x);
            pg8::EpiRes E{P_XA, P_XB, P_X, P_MODL + 2048}; pg8::gemm_phase<pg8::EpiRes, pg8::StaticOrder, true, true>(lds, g, S, E, tid); }
        SEAM(pb + 5);
        if (RUN(pb + 6)) { TIDS(); norm_phase(P_X, P_X + (size_t)32768 * 1024, a.in[25] + l * 1024, P_MODL, 3072, 4096, P_XN, gw, NGW, lane); }
        SEAM(pb + 6);
        if (RUN(pb + 7)) { TIDS(); pg8::Gemm g{P_XN, (const bf16*)(a.ws + WS_WGU), MTOK, 5632, 1024}; pg8::StaticOrder S; S.init(MTOK, 5632, G, (int)blockIdx.x);
            pg8::EpiSwiGLU E{P_PB}; pg8::gemm_phase<pg8::EpiSwiGLU, pg8::StaticOrder, true, true>(lds, g, S, E, tid); }
        SEAM(pb + 7);
        if (RUN(pb + 8)) { TIDS(); pg8::Gemm g{P_PB, (const bf16*)(a.ws + WS_WDN), MTOK, 1024, DFF}; pg8::StaticOrder S; S.init(MTOK, 1024, G, (int)blockIdx.x);
            pg8::EpiRes E{P_X, P_X + (size_t)32768 * 1024, P_X, P_MODL + 5120}; pg8::gemm_phase<pg8::EpiRes, pg8::StaticOrder, true, true>(lds, g, S, E, tid); }
        SEAM(pb + 8);
    }
    if (RUN(37)) { TIDS(); final_norm_phase(P_X, a.in[28], gw, NGW, lane); }
#undef RUN
#undef SEAM
}
constexpr int N_PHASES = 38;
#ifndef MK_COOP
#define MK_COOP 1
#endif

extern "C" void kernel_launch(void* const* d_in, const int* in_sizes, int n_in, void* d_out, int out_size, void* d_ws, size_t ws_size, hipStream_t stream) {
    static int grid = 0;
    if (grid == 0) {
        if (n_in != 29 || out_size != MTOK * DM || ws_size < WS_END) { fprintf(stderr, "kernel_launch: unexpected shapes n_in %d out %d ws %zu (need %zu)\n", n_in, out_size, ws_size, (size_t)WS_END); grid = -1; return; }
        int dev = 0, cus = 0, per_cu = 0;
        hipGetDevice(&dev); hipDeviceGetAttribute(&cus, hipDeviceAttributeMultiprocessorCount, dev);
        hipFuncSetAttribute((const void*)fwd_kernel<true>, hipFuncAttributeMaxDynamicSharedMemorySize, LDS_BYTES);
        hipFuncSetAttribute((const void*)fwd_kernel<false>, hipFuncAttributeMaxDynamicSharedMemorySize, LDS_BYTES);
        hipOccupancyMaxActiveBlocksPerMultiprocessor(&per_cu, (const void*)fwd_kernel<true>, NTHR, LDS_BYTES);
        if (per_cu < 1) per_cu = 1;
        (void)hipGetLastError();
        grid = cus * per_cu;
    }
    if (grid < 0) return;
#if MK_COOP
    if (hipMemsetAsync(d_ws, 0, 16384, stream) != hipSuccess) { fprintf(stderr, "kernel_launch: memset of the barrier words failed\n"); return; }
#endif
    Args a{};
    for (int i = 0; i < 29; ++i) a.in[i] = (const float*)d_in[i];
    a.out = (float*)d_out; a.ws = (unsigned char*)d_ws;
#if MK_COOP
    a.ph_lo = 0; a.ph_hi = N_PHASES;
    void* args[] = {&a};
    hipError_t e = hipLaunchCooperativeKernel((const void*)fwd_kernel<true>, dim3(grid), dim3(NTHR), args, LDS_BYTES, stream);
    if (e != hipSuccess) fprintf(stderr, "cooperative launch failed: %s (grid %d)\n", hipGetErrorString(e), grid);
#else
    for (int p = 0; p < N_PHASES; ++p) { a.ph_lo = p; a.ph_hi = p + 1; hipLaunchKernelGGL(fwd_kernel<false>, dim3(grid), dim3(NTHR), LDS_BYTES, stream, a); }
#endif
}
```

```cpp
#include <hip/hip_runtime.h>
#include <hip/hip_cooperative_groups.h>
#include <cstdio>
#include <cstdint>
namespace cg = cooperative_groups;
namespace pg8 {
#define PG8_LAS __attribute__((address_space(3)))
typedef unsigned short bf16_t;
typedef short bf16x8 __attribute__((ext_vector_type(8)));
typedef float f32x4 __attribute__((ext_vector_type(4)));
typedef unsigned u32x4 __attribute__((ext_vector_type(4)));
constexpr int BM = 256, BK = 64, HALF = 128, HTB = HALF * BK * 2  , STAGE_BYTES = 8 * HTB, NXCD = 8, WGM = 8;

__host__ __device__ __forceinline__ int lds_byte(int r, int c) { const int st = (r >> 4) * 2 + (c >> 5), rr = r & 15, cc = c & 31, ob = rr * 64 + cc * 2; return st * 1024 + (ob ^ (((ob >> 9) & 1) << 5)); }
__host__ __device__ __forceinline__ void stage_rc(int b, int& R, int& C) { const int st = b / 1024, sb = b % 1024, swz = sb ^ (((sb >> 9) & 1) << 5); R = (st >> 1) * 16 + swz / 64; C = (st & 1) * 32 + (swz % 64) / 2; }
__host__ __device__ __forceinline__ int perm32(int rho) { const int n = rho >> 4, i = rho & 15; return 8 * (i >> 2) + 4 * n + (i & 3); }

struct Unit { int pm, pn; };
struct Gemm { const bf16_t* A; const bf16_t* Bt; int M, N, K; };

struct StaticOrder {
    int nM, nN, nwg, G, c;
    __host__ __device__ void init(int M, int N, int G_, int c_) { nM = M / BM; nN = N / BM; nwg = nM * nN; G = G_; c = c_; }
    __host__ __device__ bool next(int i, Unit& u) const {
        const long L = (long)i * G + c; if (L >= nwg) return false;
        int wgid = (int)L; { const int q = nwg / NXCD, r = nwg % NXCD, xcd = wgid % NXCD, off = wgid / NXCD; wgid = (xcd < r ? xcd * (q + 1) : r * (q + 1) + (xcd - r) * q) + off; }
        const int nig = WGM * nN, gid = wgid / nig, fm = gid * WGM, gsz = (nM - fm) < WGM ? (nM - fm) : WGM;
        u.pm = fm + ((wgid % nig) % gsz); u.pn = (wgid % nig) / gsz; return true;
    }
    __device__ __forceinline__ void a_ready(const Unit&) const {}
    __device__ __forceinline__ void done(const Unit&) const {}
};


typedef __bf16 bf16v2_t __attribute__((ext_vector_type(2)));
typedef float f32v2_t __attribute__((ext_vector_type(2)));
__device__ __forceinline__ unsigned cvt_pk_bf16(float lo, float hi) { const f32v2_t v = {lo, hi}; const bf16v2_t b = __builtin_convertvector(v, bf16v2_t); return __builtin_bit_cast(unsigned, b); }
__device__ __forceinline__ int batch_of_row(int row) { return row < 32768 ? (row >> 11) : 16; }

struct EpiBf16 {
    static constexpr bool PERM = true, AFTER_DRAIN = false;
    bf16_t* O; int ldc;
    __device__ __forceinline__ void operator()(const f32x4 (&acc)[2][2][4][2], const Unit& u, int wr, int wc, int fr, int fq) const {
        const int row0 = u.pm * BM + wr * 64 + fr; const int col0 = u.pn * BM + wc * 32 + 8 * fq;
#pragma unroll
        for (int ai = 0; ai < 2; ++ai)
#pragma unroll
            for (int m = 0; m < 4; ++m) { bf16_t* rowp = O + (size_t)(row0 + ai * HALF + m * 16) * ldc + col0;
#pragma unroll
                for (int bj = 0; bj < 2; ++bj) { const f32x4 v0 = acc[ai][bj][m][0], v1 = acc[ai][bj][m][1];
                    u32x4 w; w.x = cvt_pk_bf16(v0[0], v0[1]); w.y = cvt_pk_bf16(v0[2], v0[3]); w.z = cvt_pk_bf16(v1[0], v1[1]); w.w = cvt_pk_bf16(v1[2], v1[3]);
                    *(u32x4*)(rowp + bj * HALF) = w; } }
    }
};
__device__ __forceinline__ float silu_f(float g) { return g * __builtin_amdgcn_rcpf(1.f + __expf(-g)); }
struct EpiSwiGLU {
    static constexpr bool PERM = true, AFTER_DRAIN = false;
    bf16_t* O;
    __device__ __forceinline__ void operator()(const f32x4 (&acc)[2][2][4][2], const Unit& u, int wr, int wc, int fr, int fq) const {
        const int row0 = u.pm * BM + wr * 64 + fr; const int col0 = u.pn * 128 + wc * 32 + 8 * fq;
#pragma unroll
        for (int ai = 0; ai < 2; ++ai)
#pragma unroll
            for (int m = 0; m < 4; ++m) { bf16_t* rowp = O + (size_t)(row0 + ai * HALF + m * 16) * 2816 + col0;
                const f32x4 g0 = acc[ai][0][m][0], g1 = acc[ai][0][m][1], u0 = acc[ai][1][m][0], u1 = acc[ai][1][m][1];
                u32x4 w;
                w.x = cvt_pk_bf16(silu_f(g0[0]) * u0[0], silu_f(g0[1]) * u0[1]); w.y = cvt_pk_bf16(silu_f(g0[2]) * u0[2], silu_f(g0[3]) * u0[3]);
                w.z = cvt_pk_bf16(silu_f(g1[0]) * u1[0], silu_f(g1[1]) * u1[1]); w.w = cvt_pk_bf16(silu_f(g1[2]) * u1[2], silu_f(g1[3]) * u1[3]);
                *(u32x4*)rowp = w; }
    }
};
struct EpiRes {
    static constexpr bool PERM = false, AFTER_DRAIN = false;
    const float* base_a; const float* base_b; float* out; const float* gate;
    __device__ __forceinline__ void operator()(const f32x4 (&acc)[2][2][4][2], const Unit& u, int wr, int wc, int fr, int fq) const {
        const int row0 = u.pm * BM + wr * 64 + fr; const int b = batch_of_row(u.pm * BM); const int col0 = u.pn * BM + wc * 32 + 4 * fq;
        f32x4 gv[2][2];
#pragma unroll
        for (int bj = 0; bj < 2; ++bj)
#pragma unroll
            for (int n = 0; n < 2; ++n) gv[bj][n] = *(const f32x4*)(gate + (size_t)b * 6144 + col0 + bj * HALF + n * 16);
#pragma unroll
        for (int ai = 0; ai < 2; ++ai)
#pragma unroll
            for (int m = 0; m < 4; ++m) { const int row = row0 + ai * HALF + m * 16;
                const float* bp = row < 32768 ? base_a + (size_t)row * 1024 : base_b + (size_t)(row - 32768) * 1024; float* op = out + (size_t)row * 1024;
#pragma unroll
                for (int bj = 0; bj < 2; ++bj)
#pragma unroll
                    for (int n = 0; n < 2; ++n) { const int c = col0 + bj * HALF + n * 16; const f32x4 o = *(const f32x4*)(bp + c) + gv[bj][n] * acc[ai][bj][m][n]; *(f32x4*)(op + c) = o; }
                if (m & 1) asm volatile("" ::: "memory"); }
    }
};

template <class Epi, class Sched, bool ALIGN_EPI = false, bool SP2 = false>
__device__ __forceinline__ void gemm_phase(PG8_LAS unsigned char* lds, const Gemm g, const Sched& S, const Epi& E, int tid_in) {
    int tid_ = tid_in; asm volatile("" : "+v"(tid_)); const int tid = tid_, wid = __builtin_amdgcn_readfirstlane(tid >> 6), lane = tid & 63, wr = wid >> 2, wc = wid & 3, fr = lane & 15, fq = lane >> 4;
    const int K = g.K, nt = K / BK;
    unsigned voffA[2], voffB[2];
#pragma unroll
    for (int i = 0; i < 2; ++i) { int R, C; stage_rc(tid * 16 + i * 8192, R, C); const int Rb = Epi::PERM ? ((R & ~31) + perm32(R & 31)) : R;
        voffA[i] = (unsigned)(R * K + C) * 2u; voffB[i] = (unsigned)(Rb * K + C) * 2u; }
    const size_t kstep = (size_t)(BK * 2);
    const size_t hstep = (size_t)HALF * K * 2;
    const size_t tstep = 2 * hstep;
    const unsigned ldsw = (unsigned)wid * 1024u;
    const int aoff = lds_byte(wr * 64 + fr, fq * 8), boff = lds_byte(wc * 32 + fr, fq * 8);
#define PG8_SA(b, h) (((b) * 2 + (h)) * HTB)
#define PG8_SB(b, h) ((4 + (b) * 2 + (h)) * HTB)
#define PG8_STAGE(bufoff, gbase, voff) do { _Pragma("unroll") for (int _i = 0; _i < 2; ++_i) \
        __builtin_amdgcn_global_load_lds((const unsigned*)((const char*)(gbase) + (voff)[_i]), (PG8_LAS unsigned*)(lds + (bufoff) + ldsw + _i * 8192), 16, 0, 0); } while (0)
#define PG8_LDA(dst, b, h) do { _Pragma("unroll") for (int m = 0; m < 4; ++m) _Pragma("unroll") for (int k = 0; k < 2; ++k) dst[m][k] = *(const PG8_LAS bf16x8*)(lds + PG8_SA(b, h) + aoff + m * 2048 + k * 1024); } while (0)
#define PG8_LDB(dst, b, h) do { _Pragma("unroll") for (int n = 0; n < 2; ++n) _Pragma("unroll") for (int k = 0; k < 2; ++k) dst[n][k] = *(const PG8_LAS bf16x8*)(lds + PG8_SB(b, h) + boff + n * 2048 + k * 1024); } while (0)
#define PG8_MMA(ai, bj, At, Bt) do { __builtin_amdgcn_s_setprio(1); _Pragma("unroll") for (int m = 0; m < 4; ++m) _Pragma("unroll") for (int n = 0; n < 2; ++n) _Pragma("unroll") for (int k = 0; k < 2; ++k) \
        acc[ai][bj][m][n] = __builtin_amdgcn_mfma_f32_16x16x32_bf16(Bt[n][k], At[m][k], acc[ai][bj][m][n], 0, 0, 0); __builtin_amdgcn_s_setprio(0); } while (0)
#define PG8_WAIT_V(n) asm volatile("s_waitcnt vmcnt(" #n ")" ::: "memory")
#define PG8_WAIT_L(n) asm volatile("s_waitcnt lgkmcnt(" #n ")" ::: "memory")
#define PG8_BAR __builtin_amdgcn_s_barrier()
#define PG8_SCHED __builtin_amdgcn_sched_barrier(0)
    Unit cur, nxt; int ui = 0;
    if (!S.next(0, cur)) return;
    f32x4 acc[2][2][4][2];
#pragma unroll
    for (int a = 0; a < 2; ++a)
#pragma unroll
        for (int b = 0; b < 2; ++b)
#pragma unroll
            for (int m = 0; m < 4; ++m)
#pragma unroll
                for (int n = 0; n < 2; ++n) acc[a][b][m][n] = (f32x4){0.f, 0.f, 0.f, 0.f};
    bf16x8 At[4][2], B0[2][2], B1[2][2];
    const char* cA = (const char*)g.A + (size_t)cur.pm * tstep; const char* cB = (const char*)g.Bt + (size_t)cur.pn * tstep;
    S.a_ready(cur);
    if constexpr (SP2) {
        PG8_STAGE(PG8_SB(0, 0), cB, voffB); PG8_STAGE(PG8_SB(0, 1), cB + hstep, voffB); PG8_STAGE(PG8_SA(0, 0), cA, voffA); PG8_STAGE(PG8_SA(0, 1), cA + hstep, voffA);
        if (wr == 1) PG8_BAR;
        PG8_WAIT_V(2); PG8_BAR;
        PG8_STAGE(PG8_SB(1, 0), cB + kstep, voffB); PG8_STAGE(PG8_SA(1, 0), cA + kstep, voffA); PG8_STAGE(PG8_SB(1, 1), cB + hstep + kstep, voffB);
        PG8_WAIT_V(6); PG8_BAR;
    } else {
        PG8_STAGE(PG8_SB(0, 0), cB, voffB); PG8_STAGE(PG8_SA(0, 0), cA, voffA); PG8_STAGE(PG8_SB(0, 1), cB + hstep, voffB); PG8_STAGE(PG8_SA(0, 1), cA + hstep, voffA);
        if (wr == 1) PG8_BAR;
        PG8_WAIT_V(4); PG8_BAR;
        PG8_STAGE(PG8_SB(1, 0), cB + kstep, voffB); PG8_STAGE(PG8_SA(1, 0), cA + kstep, voffA); PG8_STAGE(PG8_SB(1, 1), cB + hstep + kstep, voffB);
        PG8_WAIT_V(6); PG8_BAR;
    }
    for (;;) {
        const bool has_next = S.next(ui + 1, nxt);
        const char* nA = has_next ? (const char*)g.A + (size_t)nxt.pm * tstep : cA; const char* nB = has_next ? (const char*)g.Bt + (size_t)nxt.pn * tstep : cB;
        for (int t = 0; t < nt; t += 2) {
            const bool last = (t == nt - 2);
            const char* a1 = cA + (size_t)(t + 1) * kstep;
            const char* a2 = last ? nA : cA + (size_t)(t + 2) * kstep; const char* b2 = last ? nB : cB + (size_t)(t + 2) * kstep;
            const char* a3 = a2 + kstep; const char* b3 = b2 + kstep;
            if (last && has_next) S.a_ready(nxt);
            if constexpr (SP2) {
            PG8_LDB(B0, 0, 0); PG8_LDB(B1, 0, 1); PG8_SCHED; PG8_LDA(At, 0, 0); PG8_STAGE(PG8_SA(1, 1), a1 + hstep, voffA);
            PG8_WAIT_V(8); PG8_WAIT_L(0); PG8_BAR; PG8_MMA(0, 0, At, B0); PG8_MMA(0, 1, At, B1); PG8_BAR; PG8_SCHED;
            PG8_LDA(At, 0, 1); PG8_STAGE(PG8_SB(0, 0), b2, voffB); PG8_STAGE(PG8_SB(0, 1), b2 + hstep, voffB); PG8_STAGE(PG8_SA(0, 0), a2, voffA);
            PG8_WAIT_V(8); PG8_WAIT_L(0); PG8_BAR; PG8_MMA(1, 0, At, B0); PG8_MMA(1, 1, At, B1); PG8_BAR; PG8_SCHED;
            PG8_LDB(B0, 1, 0); PG8_LDB(B1, 1, 1); PG8_SCHED; PG8_LDA(At, 1, 0); PG8_STAGE(PG8_SA(0, 1), a2 + hstep, voffA);
            PG8_WAIT_V(8); PG8_WAIT_L(0); PG8_BAR; PG8_MMA(0, 0, At, B0); PG8_MMA(0, 1, At, B1); PG8_BAR; PG8_SCHED;
            PG8_LDA(At, 1, 1); PG8_STAGE(PG8_SB(1, 0), b3, voffB); PG8_STAGE(PG8_SB(1, 1), b3 + hstep, voffB); PG8_STAGE(PG8_SA(1, 0), a3, voffA);
            PG8_WAIT_V(8); PG8_WAIT_L(0); PG8_BAR; PG8_MMA(1, 0, At, B0); PG8_MMA(1, 1, At, B1); PG8_BAR; PG8_SCHED;
            } else {
            PG8_LDB(B0, 0, 0); PG8_SCHED; PG8_LDA(At, 0, 0); PG8_STAGE(PG8_SA(1, 1), a1 + hstep, voffA);
            PG8_WAIT_L(8); PG8_BAR; PG8_WAIT_L(0); PG8_MMA(0, 0, At, B0); PG8_BAR; PG8_SCHED;
            PG8_LDB(B1, 0, 1); PG8_STAGE(PG8_SB(0, 0), b2, voffB);
            PG8_BAR; PG8_WAIT_L(0); PG8_MMA(0, 1, At, B1); PG8_BAR;
            PG8_LDA(At, 0, 1); PG8_STAGE(PG8_SA(0, 0), a2, voffA);
            PG8_BAR; PG8_WAIT_L(0); PG8_MMA(1, 0, At, B0); PG8_BAR; PG8_SCHED;
            PG8_STAGE(PG8_SB(0, 1), b2 + hstep, voffB);
            PG8_WAIT_V(6); PG8_BAR; PG8_MMA(1, 1, At, B1); PG8_BAR;
            PG8_LDB(B0, 1, 0); PG8_SCHED; PG8_LDA(At, 1, 0); PG8_STAGE(PG8_SA(0, 1), a2 + hstep, voffA);
            PG8_WAIT_L(8); PG8_BAR; PG8_WAIT_L(0); PG8_MMA(0, 0, At, B0); PG8_BAR; PG8_SCHED;
            PG8_LDB(B1, 1, 1); PG8_STAGE(PG8_SB(1, 0), b3, voffB);
            PG8_BAR; PG8_WAIT_L(0); PG8_MMA(0, 1, At, B1); PG8_BAR;
            PG8_LDA(At, 1, 1); PG8_STAGE(PG8_SA(1, 0), a3, voffA);
            PG8_BAR; PG8_WAIT_L(0); PG8_MMA(1, 0, At, B0); PG8_BAR; PG8_SCHED;
            PG8_STAGE(PG8_SB(1, 1), b3 + hstep, voffB);
            PG8_WAIT_V(6); PG8_BAR; PG8_MMA(1, 1, At, B1); PG8_BAR;
            }
        }
        if constexpr (ALIGN_EPI) { if (wr == 0) PG8_BAR; }
        if constexpr (!Epi::AFTER_DRAIN) { E(acc, cur, wr, wc, fr, fq); S.done(cur); }
        if (!has_next) break;
#pragma unroll
        for (int a = 0; a < 2; ++a)
#pragma unroll
            for (int b = 0; b < 2; ++b)
#pragma unroll
                for (int m = 0; m < 4; ++m)
#pragma unroll
                    for (int n = 0; n < 2; ++n) acc[a][b][m][n] = (f32x4){0.f, 0.f, 0.f, 0.f};
        cur = nxt; cA = nA; cB = nB; ++ui;
        if constexpr (ALIGN_EPI) { if (wr == 1) PG8_BAR; }
    }
    PG8_WAIT_V(0);
    if constexpr (!ALIGN_EPI) { if (wr == 0) PG8_BAR; }
    PG8_BAR;
    if constexpr (Epi::AFTER_DRAIN) { E.fused(acc, cur, wr, wc, fr, fq, lds, wid, lane); S.done(cur); }
#undef PG8_SA
#undef PG8_SB
#undef PG8_STAGE
#undef PG8_LDA
#undef PG8_LDB
#undef PG8_MMA
#undef PG8_WAIT_V
#undef PG8_WAIT_L
#undef PG8_BAR
#undef PG8_SCHED
}
}

constexpr int MTOK = 49152, DM = 1024, NBATCH = 17, NLAYER = 4, PIN = 2944, PLD = 3072, DFF = 2816, NMOD = 6144;
constexpr int NWAVES = 8, NTHR = 512;
constexpr float EPS_F = 1e-6f, GN_EPS_F = 64e-5f;
constexpr size_t MiB = 1u << 20;
constexpr size_t WS_MOD = 1 * MiB;
constexpr size_t WS_WIN = 3 * MiB;
constexpr size_t WS_WOUT = 9 * MiB;
constexpr size_t WS_WGU = 11 * MiB;
constexpr size_t WS_WDN = 22 * MiB;
constexpr size_t WS_WSP = 27 * MiB + 512 * 1024;
constexpr size_t WS_XN = 28 * MiB;
constexpr size_t WS_P = 124 * MiB;
constexpr size_t WS_SB = 508 * MiB;
constexpr size_t WS_LORA = 444 * MiB;
constexpr size_t WS_END = 510 * MiB;
constexpr int LDS_BYTES = 153600;

#define LAS __attribute__((address_space(3)))
typedef unsigned short bf16;
typedef unsigned v4u __attribute__((ext_vector_type(4)));
typedef unsigned v2u __attribute__((ext_vector_type(2)));
typedef float f32x4 __attribute__((ext_vector_type(4)));
typedef float f32x16 __attribute__((ext_vector_type(16)));
typedef short bf16x8 __attribute__((ext_vector_type(8)));
#define LDS_WAIT() asm volatile("s_waitcnt lgkmcnt(0)" ::: "memory")
typedef __bf16 bf16v2_t __attribute__((ext_vector_type(2)));
typedef float f32v2_t __attribute__((ext_vector_type(2)));
__device__ __forceinline__ unsigned pk2(float lo, float hi) { const f32v2_t v = {lo, hi}; const bf16v2_t b = __builtin_convertvector(v, bf16v2_t); return __builtin_bit_cast(unsigned, b); }
__device__ __forceinline__ unsigned f2bf(float f) { return pk2(f, f) & 0xffffu; }
__device__ __forceinline__ float bf2f(unsigned h) { return __builtin_bit_cast(float, h << 16); }
__device__ __forceinline__ float ldbf(const bf16* p) { return bf2f((unsigned)*p); }
template <int CTRL> __device__ __forceinline__ float dpp_f(float v) { return __builtin_bit_cast(float, __builtin_amdgcn_update_dpp(0, __builtin_bit_cast(int, v), CTRL, 0xF, 0xF, true)); }
typedef float f32x2 __attribute__((ext_vector_type(2)));
__device__ __forceinline__ float red16(float p) { p += dpp_f<0xB1>(p); p += dpp_f<0x4E>(p); p += dpp_f<0x141>(p); p += dpp_f<0x140>(p); return p; }
__device__ __forceinline__ float wave_sum(float v) {
    v = red16(v); const int x = __builtin_bit_cast(int, v);
    const float a = __builtin_bit_cast(float, __builtin_amdgcn_readlane(x, 0)), b = __builtin_bit_cast(float, __builtin_amdgcn_readlane(x, 16)), c = __builtin_bit_cast(float, __builtin_amdgcn_readlane(x, 32)), d = __builtin_bit_cast(float, __builtin_amdgcn_readlane(x, 48));
    return (a + b) + (c + d);
}
__device__ __forceinline__ float red8(float p) { p += dpp_f<0xB1>(p); p += dpp_f<0x4E>(p); p += dpp_f<0x141>(p); return p; }
__device__ __forceinline__ float gelu_f(float v) {
    const float t = __builtin_amdgcn_rcpf(fabsf(v) * 0.2316418882f + 1.0f);
    float q = t * 0.5307027145f + (-0.7265760135f); q = q * t + 0.7107068705f; q = q * t + (-0.142248368f); q = q * t + 0.127414796f; q = q * t;
    const float e = __builtin_amdgcn_exp2f((v * v) * (-0.72134752044f)); const float m = v * (q * e);
    return v < 0.f ? m : v - m;
}
__device__ __forceinline__ float sigmoid_f(float x) { return 1.f / (1.f + __expf(-x)); }

struct Args { const float* in[29]; float* out; unsigned char* ws; int ph_lo, ph_hi; };

__device__ __forceinline__ void transpose_item(const float* W, int K, int N, bf16* WT, int kb, int nb, int row_off, LAS float* scr, int lane) {
    const int k0 = 64 * kb, n0 = 32 * nb;
#pragma unroll 8
    for (int i = 0; i < 32; ++i) { const int kk = 2 * i + (lane >> 5); scr[kk * 33 + (lane & 31)] = W[(size_t)(k0 + kk) * N + n0 + (lane & 31)]; }
    LDS_WAIT(); asm volatile("" ::: "memory");
    const int c = lane & 7;
#pragma unroll
    for (int j = 0; j < 4; ++j) { const int n = (lane >> 3) + 8 * j; const LAS float* s = scr + (8 * c) * 33 + n;
        v4u o; o.x = pk2(s[0 * 33], s[1 * 33]); o.y = pk2(s[2 * 33], s[3 * 33]); o.z = pk2(s[4 * 33], s[5 * 33]); o.w = pk2(s[6 * 33], s[7 * 33]);
        *(v4u*)(WT + (size_t)(row_off + n0 + n) * K + k0 + 8 * c) = o; }
    LDS_WAIT(); asm volatile("" ::: "memory");
}
__device__ __forceinline__ void convert_weights(const Args& a, int l, LAS unsigned char* lds, int gw, int NGW, int wave, int lane) {
    LAS float* scr = (LAS float*)(lds + wave * 16384);
    const float* w_in = a.in[7] + (size_t)l * 1024 * PIN; const float* w_out = a.in[24] + (size_t)l * 1024 * 1024;
    const float* w_gu = a.in[26] + (size_t)l * 1024 * 5632; const float* w_dn = a.in[27] + (size_t)l * DFF * 1024;
    bf16* Win = (bf16*)(a.ws + WS_WIN); bf16* Wout = (bf16*)(a.ws + WS_WOUT); bf16* Wgu = (bf16*)(a.ws + WS_WGU); bf16* Wdn = (bf16*)(a.ws + WS_WDN);
    constexpr int I_IN = 16 * 92, I_OUT = 16 * 32, I_GU = 16 * 176, I_DN = 44 * 32, I_PAD = 128;
    constexpr int NIT = I_IN + I_OUT + I_GU + I_DN + I_PAD;
    {
        bf16* LW = (bf16*)(a.ws + WS_LORA); bf16* LA = LW + 65536; bf16* LG = LA + 65536;
        const float* w2 = a.in[15] + (size_t)l * 65536; const float* a2 = a.in[17] + (size_t)l * 65536; const float* g2 = a.in[18] + (size_t)l * 65536;
        for (int e = gw * 64 + lane; e < 65536; e += NGW * 64) { const int col = e & 511, i = (e >> 9) & 63, dir = e >> 15;
            const int dst = ((dir * 8 + (col >> 6)) * 64 + (col & 63)) * 64 + i; LW[dst] = (bf16)f2bf(w2[e]); LA[dst] = (bf16)f2bf(a2[e]); }
        for (int e = gw * 64 + lane; e < 65536; e += NGW * 64) { const int col = e & 511, i = e >> 9;
            LG[((col >> 6) * 64 + (col & 63)) * 128 + i] = (bf16)f2bf(g2[e]); }
    }
    for (int it = gw; it < NIT; it += NGW) {
        int r = it;
        if (r < I_IN) { transpose_item(w_in, 1024, PIN, Win, r / 92, r % 92, 0, scr, lane); continue; } r -= I_IN;
        if (r < I_OUT) { transpose_item(w_out, 1024, 1024, Wout, r / 32, r % 32, 0, scr, lane); continue; } r -= I_OUT;
        if (r < I_GU) { const int kb = r / 176, nb = r % 176; const int n0 = 32 * nb; const int up = n0 >= DFF ? 1 : 0; const int j0 = n0 - up * DFF;
            const int dest = 256 * (j0 >> 7) + 128 * up + (j0 & 127);
            transpose_item(w_gu, 1024, 5632, Wgu, kb, nb, dest - n0, scr, lane); continue; } r -= I_GU;
        if (r < I_DN) { transpose_item(w_dn, DFF, 1024, Wdn, r / 32, r % 32, 0, scr, lane); continue; } r -= I_DN;
        { v4u z = {0u, 0u, 0u, 0u}; v4u* p = (v4u*)(Win + (size_t)(PIN + r) * 1024);
          p[lane] = z; p[lane + 64] = z; }
    }
}

__device__ __forceinline__ void mod_phase(const Args& a, LAS unsigned char* lds, int tid) {
    LAS float* sc = (LAS float*)lds;
    LAS float* part = (LAS float*)(lds + 81920);
    const float* cp = a.in[2]; const float* cs = a.in[3];
    for (int e = tid; e < 20 * 1024; e += NTHR) { const int b = e >> 10, k = e & 1023; float v = 0.f;
        if (b < 17) { const float cv = b < 16 ? cp[b * 1024 + k] : cs[k]; v = cv / (1.f + __expf(-cv)); }
        sc[k * 20 + b] = v; }
    __syncthreads();
    float* mod = (float*)(a.ws + WS_MOD);
    const int col = tid & 63, kg = tid >> 6;
    for (int item = blockIdx.x; item < 4 * 96; item += gridDim.x) {
        const int l = item / 96, n0 = (item % 96) * 64;
        float acc[17];
#pragma unroll
        for (int b = 0; b < 17; ++b) acc[b] = 0.f;
        const float* wp = a.in[4] + ((size_t)l * 1024 + kg * 128) * NMOD + n0 + col;
#pragma unroll 16
        for (int kk = 0; kk < 128; ++kk) { const float w = wp[(size_t)kk * NMOD]; const LAS float* s = sc + (kg * 128 + kk) * 20;
            const f32x4 s0 = *(const LAS f32x4*)(s), s1 = *(const LAS f32x4*)(s + 4), s2 = *(const LAS f32x4*)(s + 8), s3 = *(const LAS f32x4*)(s + 12); const float s4 = s[16];
#pragma unroll
            for (int j = 0; j < 4; ++j) { acc[j] += s0[j] * w; acc[4 + j] += s1[j] * w; acc[8 + j] += s2[j] * w; acc[12 + j] += s3[j] * w; }
            acc[16] += s4 * w; }
#pragma unroll
        for (int b = 0; b < 17; ++b) part[(kg * 17 + b) * 64 + col] = acc[b];
        __syncthreads();
        for (int e = tid; e < 17 * 64; e += NTHR) { const int b = e >> 6, cc = e & 63; float s = 0.f;
#pragma unroll
            for (int g = 0; g < 8; ++g) s += part[(g * 17 + b) * 64 + cc];
            mod[((size_t)l * 17 + b) * NMOD + n0 + cc] = s + a.in[5][l * NMOD + n0 + cc]; }
        __syncthreads();
    }
    { bf16* wsp = (bf16*)(a.ws + WS_WSP); const float* src = a.in[10];
      for (int e = blockIdx.x * NTHR + tid; e < 262144 / 2; e += gridDim.x * NTHR) ((unsigned*)wsp)[e] = pk2(src[2 * e], src[2 * e + 1]); }
}

constexpr int NR = 4;
__device__ __forceinline__ void norm_phase(const float* xa, const float* xb, const float* g, const float* modl, int sh_off, int sc_off, bf16* XN, int gw, int NGW, int lane) {
    for (int row0 = gw; row0 < MTOK; row0 += NR * NGW) {
        f32x4 v[NR][4]; float s[NR];
#pragma unroll
        for (int q = 0; q < NR; ++q) { const int row = row0 + q * NGW; s[q] = 0.f; if (row < MTOK) { const float* xr = row < 32768 ? xa + (size_t)row * 1024 : xb + (size_t)(row - 32768) * 1024;
#pragma unroll
            for (int j = 0; j < 4; ++j) v[q][j] = ((const f32x4*)xr)[lane + 64 * j]; } }
#pragma unroll
        for (int q = 0; q < NR; ++q) if (row0 + q * NGW < MTOK) {
#pragma unroll
            for (int j = 0; j < 4; ++j) s[q] += (v[q][j].x * v[q][j].x + v[q][j].y * v[q][j].y) + (v[q][j].z * v[q][j].z + v[q][j].w * v[q][j].w); }
#pragma unroll
        for (int q = 0; q < NR; ++q) if (row0 + q * NGW < MTOK) { const int row = row0 + q * NGW; const int b = pg8::batch_of_row(row);
            const float rstd = rsqrtf(wave_sum(s[q]) * (1.f / 1024.f) + EPS_F);
            const float* mb = modl + (size_t)b * NMOD;
#pragma unroll
            for (int j = 0; j < 4; ++j) { const int col = 4 * lane + 256 * j;
                const f32x4 gv = *(const f32x4*)(g + col), scv = *(const f32x4*)(mb + sc_off + col), shv = *(const f32x4*)(mb + sh_off + col);
                const f32x4 o = v[q][j] * rstd * gv * (scv + 1.f) + shv;
                v2u w; w.x = pk2(o.x, o.y); w.y = pk2(o.z, o.w); *(v2u*)(XN + (size_t)row * 1024 + col) = w; } }
    }
}
__device__ __forceinline__ void final_norm_phase(float* x, const float* g, int gw, int NGW, int lane) {
    for (int row0 = gw; row0 < MTOK; row0 += NR * NGW) {
        f32x4 v[NR][4]; float s[NR];
#pragma unroll
        for (int q = 0; q < NR; ++q) { s[q] = 0.f; if (row0 + q * NGW < MTOK) { const float* xr = x + (size_t)(row0 + q * NGW) * 1024;
#pragma unroll
            for (int j = 0; j < 4; ++j) v[q][j] = ((const f32x4*)xr)[lane + 64 * j]; } }
#pragma unroll
        for (int q = 0; q < NR; ++q) if (row0 + q * NGW < MTOK) {
#pragma unroll
            for (int j = 0; j < 4; ++j) s[q] += (v[q][j].x * v[q][j].x + v[q][j].y * v[q][j].y) + (v[q][j].z * v[q][j].z + v[q][j].w * v[q][j].w); }
#pragma unroll
        for (int q = 0; q < NR; ++q) if (row0 + q * NGW < MTOK) { float* xr = x + (size_t)(row0 + q * NGW) * 1024; const float rstd = rsqrtf(wave_sum(s[q]) * (1.f / 1024.f) + EPS_F);
#pragma unroll
            for (int j = 0; j < 4; ++j) { const f32x4 gv = *(const f32x4*)(g + 4 * lane + 256 * j); ((f32x4*)xr)[lane + 64 * j] = v[q][j] * rstd * gv; } }
    }
}

__device__ __forceinline__ void mixer_a_item(LAS unsigned char* lds, const Args& a, int l, int item, int tid, int wave, int lane) {
    const bf16* P = (const bf16*)(a.ws + WS_P); bf16* Y = (bf16*)(a.ws + WS_XN); const bf16* wsp = (const bf16*)(a.ws + WS_WSP) + (size_t)l * 65536;
    const float* ln_w = a.in[8] + l * 512; const float* ln_b = a.in[9] + l * 512; const float* b_sp = a.in[11] + l * 512; const float* out_g = a.in[12] + l * 512;
    const int c = item >> 2, h = item & 3, r0 = c * 128;
    LAS bf16* vnT = (LAS bf16*)lds;
    LAS float* ob = (LAS float*)(lds + 34816);
    {
        const float lw0 = ln_w[h * 128 + 2 * lane], lw1 = ln_w[h * 128 + 2 * lane + 1], lb0 = ln_b[h * 128 + 2 * lane], lb1 = ln_b[h * 128 + 2 * lane + 1];
        unsigned wv[16];
#pragma unroll
        for (int qi = 0; qi < 16; ++qi) wv[qi] = *(const unsigned*)(P + (size_t)(r0 + 16 * wave + qi) * PLD + 512 + h * 128 + 2 * lane);
#pragma unroll
        for (int qi = 0; qi < 16; ++qi) { const int q = 16 * wave + qi; const unsigned w = wv[qi];
            const float v0 = gelu_f(bf2f(w & 0xffffu)), v1 = gelu_f(bf2f(w >> 16));
            const float mu = wave_sum(v0 + v1) * (1.f / 128.f); const float d0 = v0 - mu, d1 = v1 - mu;
            const float rstd = rsqrtf(wave_sum(d0 * d0 + d1 * d1) * (1.f / 128.f) + EPS_F);
            vnT[(2 * lane) * 136 + q] = (bf16)f2bf(d0 * rstd * lw0 + lb0); vnT[(2 * lane + 1) * 136 + q] = (bf16)f2bf(d1 * rstd * lw1 + lb1); }
    }
    __syncthreads();
    const int wp = wave >> 1, wd = wave & 1, l31 = lane & 31, hi = lane >> 5;
    f32x16 acc[2];
#pragma unroll
    for (int t = 0; t < 2; ++t)
#pragma unroll
        for (int r = 0; r < 16; ++r) acc[t][r] = 0.f;
#pragma unroll
    for (int ks = 0; ks < 8; ++ks) { const int k0 = 16 * ks;
        const bf16x8 af = *(const bf16x8*)(wsp + (size_t)h * 16384 + (32 * wp + l31) * 128 + k0 + 8 * hi);
#pragma unroll
        for (int t = 0; t < 2; ++t) { const bf16x8 bfr = *(const LAS bf16x8*)(vnT + (64 * wd + 32 * t + l31) * 136 + k0 + 8 * hi);
            acc[t] = __builtin_amdgcn_mfma_f32_32x32x16_bf16(af, bfr, acc[t], 0, 0, 0); } }
#pragma unroll
    for (int t = 0; t < 2; ++t) { const int d = 64 * wd + 32 * t + l31; float uu[16];
#pragma unroll
        for (int r = 0; r < 16; ++r) uu[r] = ldbf(P + (size_t)(r0 + 32 * wp + (r & 3) + 8 * (r >> 2) + 4 * hi) * PLD + h * 128 + d);
#pragma unroll
        for (int r = 0; r < 16; ++r) { const int p = 32 * wp + (r & 3) + 8 * (r >> 2) + 4 * hi;
            ob[p * 132 + d] = gelu_f(uu[r]) * (acc[t][r] + b_sp[h * 128 + p]); } }
    __syncthreads();
    {
        const float g0 = out_g[h * 128 + 2 * lane], g1 = out_g[h * 128 + 2 * lane + 1];
        for (int pi = 0; pi < 16; ++pi) { const int p = 16 * wave + pi; const float o0 = ob[p * 132 + 2 * lane], o1 = ob[p * 132 + 2 * lane + 1];
            const float rstd = rsqrtf(wave_sum(o0 * o0 + o1 * o1) * (1.f / 128.f) + EPS_F);
            *(unsigned*)(Y + (size_t)(r0 + p) * 1024 + h * 128 + 2 * lane) = pk2(o0 * rstd * g0, o1 * rstd * g1); }
    }
    __syncthreads();
}

__device__ __forceinline__ float ts_val(const bf16* P, size_t row, int pos, int len, int j, const float* mu) {
    const bf16* p = P + row * PLD + 1024 + j; const float pc = ldbf(p); const float pp = pos > 0 ? ldbf(p - PLD) : 0.f; const float pn = pos < len - 1 ? ldbf(p + PLD) : 0.f;
    return pc + mu[j] * (pp - pc) + mu[1920 + j] * (pn - pc);
}
constexpr size_t WS_AB = 412 * MiB;
struct ScanLds { LAS bf16 *W2t, *A2t, *G2t, *DWb, *DAb, *DGb, *Kap, *Rt, *Kt, *Bt, *Kh, *Bh, *Vt, *GVb, *Akk, *Akr, *Abr, *S16, *Ub, *U0b, *BQ, *BQT, *BW, *TiT; LAS float *Rs, *KRs, *Vs, *LWs, *LAs, *Ys, *WT, *Wend, *SBs, *MU; };
template <int NV> __device__ __forceinline__ ScanLds scan_lds(LAS unsigned char* lds) {
    ScanLds L; L.W2t = (LAS bf16*)(lds); L.A2t = (LAS bf16*)(lds + 9216); L.G2t = (LAS bf16*)(lds + 18432);
    L.Rs = (LAS float*)(lds + 36864); L.KRs = (LAS float*)(lds + 45056); L.U0b = (LAS bf16*)(lds + 36864); L.Ys = (LAS float*)(lds + 45056);
    L.Vs = (LAS float*)(lds + 53248);
    L.LWs = (LAS float*)(lds + 61440); L.LAs = (LAS float*)(lds + 69632); L.DWb = (LAS bf16*)(lds + 77824); L.DAb = (LAS bf16*)(lds + 82432); L.DGb = (LAS bf16*)(lds + 87040);
    L.S16 = (LAS bf16*)(lds + 61440); L.Ub = (LAS bf16*)(lds + 61440 + NV * 144);
    L.BQ = (LAS bf16*)(lds + 61440 + NV * 224); L.BQT = (LAS bf16*)(lds + 61440 + NV * 224 + 2560);
    if (NV == 64) { L.BW = (LAS bf16*)(lds + 61440 + NV * 224 + 5120); L.TiT = (LAS bf16*)(lds + 61440 + NV * 224 + 7680); }
    else { L.BW = (LAS bf16*)(lds + 36864 + 10240); L.TiT = (LAS bf16*)(lds + 36864 + 12800); }
    L.Kap = (LAS bf16*)(lds + 95744); L.Rt = (LAS bf16*)(lds + 100352); L.Kt = (LAS bf16*)(lds + 104960); L.Bt = (LAS bf16*)(lds + 109568);
    L.Kh = (LAS bf16*)(lds + 114176); L.Bh = (LAS bf16*)(lds + 119296); L.Vt = (LAS bf16*)(lds + 124416); L.GVb = (LAS bf16*)(lds + 124416 + 5120);
    L.WT = (LAS float*)(lds + 134656); L.Wend = (LAS float*)(lds + 136704); L.SBs = (LAS float*)(lds + 136960);
    L.MU = (LAS float*)(lds + 147456);
    L.Akk = (LAS bf16*)(lds + 137088); L.Akr = (LAS bf16*)(lds + 139648); L.Abr = (LAS bf16*)(lds + 142208); return L;
}
__device__ __forceinline__ float fast_sigmoid(float x) { return __builtin_amdgcn_rcpf(1.f + __expf(-x)); }
__device__ __forceinline__ float fast_tanh(float x) { return 1.f - 2.f * __builtin_amdgcn_rcpf(1.f + __expf(2.f * x)); }
struct ScanCh { float kkw, kaw, rkw, w0v, a0v; };
__device__ __forceinline__ f32x4 ts4(const bf16* P, size_t row, int pos, int len, int j, const float* mu) {
    const bf16* p = P + row * PLD + 1024 + j;
    const v2u c = *(const v2u*)p; v2u pv = {0u, 0u}, nv = {0u, 0u};
    if (pos > 0) pv = *(const v2u*)(p - PLD);
    if (pos < len - 1) nv = *(const v2u*)(p + PLD);
    const f32x4 pc = {bf2f(c.x & 0xffffu), bf2f(c.x >> 16), bf2f(c.y & 0xffffu), bf2f(c.y >> 16)};
    const f32x4 pp = {bf2f(pv.x & 0xffffu), bf2f(pv.x >> 16), bf2f(pv.y & 0xffffu), bf2f(pv.y >> 16)};
    const f32x4 pn = {bf2f(nv.x & 0xffffu), bf2f(nv.x >> 16), bf2f(nv.y & 0xffffu), bf2f(nv.y >> 16)};
    const f32x4 m0 = *(const f32x4*)(mu + j), m1 = *(const f32x4*)(mu + 1920 + j);
    return pc + m0 * (pp - pc) + m1 * (pn - pc);
}
struct RawQ { v2u c, p, n; };
__device__ __forceinline__ RawQ ts4_load(const bf16* P, size_t row, int pos, int len, int j) {
    const bf16* p = P + row * PLD + 1024 + j; RawQ q; q.c = *(const v2u*)p; q.p = (v2u){0u, 0u}; q.n = (v2u){0u, 0u};
    if (pos > 0) q.p = *(const v2u*)(p - PLD);
    if (pos < len - 1) q.n = *(const v2u*)(p + PLD);
    return q;
}
__device__ __forceinline__ f32x4 ts4_apply(const RawQ& q, const LAS float* MU, int grp, int col) {
    const f32x4 pc = {bf2f(q.c.x & 0xffffu), bf2f(q.c.x >> 16), bf2f(q.c.y & 0xffffu), bf2f(q.c.y >> 16)};
    const f32x4 pp = {bf2f(q.p.x & 0xffffu), bf2f(q.p.x >> 16), bf2f(q.p.y & 0xffffu), bf2f(q.p.y >> 16)};
    const f32x4 pn = {bf2f(q.n.x & 0xffffu), bf2f(q.n.x >> 16), bf2f(q.n.y & 0xffffu), bf2f(q.n.y >> 16)};
    const f32x4 m0 = *(const LAS f32x4*)(MU + (grp * 3) * 64 + col), m1 = *(const LAS f32x4*)(MU + (grp * 3 + 1) * 64 + col), c0 = *(const LAS f32x4*)(MU + (grp * 3 + 2) * 64 + col);
    return c0 * pc + m0 * pp + m1 * pn;
}
struct Raw { RawQ q[5]; RawQ g[2]; };
template <bool FULL> __device__ __forceinline__ void raw_load(Raw& R, const bf16* P, int s0, int len, int pos0, int h, int dir, bool doG, int tid) {
    const int t = tid >> 4, cq = (tid & 15) * 4; const int pos = pos0 + (dir ? 31 - t : t); const size_t row = (size_t)(s0 + pos);
    if (FULL) R.q[0] = ts4_load(P, row, pos, len, h * 64 + cq);
    R.q[1] = ts4_load(P, row, pos, len, 512 + h * 64 + cq); R.q[2] = ts4_load(P, row, pos, len, 1024 + h * 64 + cq);
    R.q[3] = ts4_load(P, row, pos, len, 1536 + dir * 64 + cq); R.q[4] = ts4_load(P, row, pos, len, 1664 + dir * 64 + cq);
    if (doG) { const int c8 = (tid & 15) * 8; R.g[0] = ts4_load(P, row, pos, len, 1792 + c8); R.g[1] = ts4_load(P, row, pos, len, 1792 + c8 + 4); }
}
__device__ __forceinline__ int mrow(int r, int hi) { return (r & 3) + 8 * (r >> 2) + 4 * hi; }
template <int KS> __device__ __forceinline__ void mm32(f32x16& acc, const LAS bf16* X, int px, int xrow0, const LAS bf16* Y, int py, int yrow0, int l31, int hi) {
#pragma unroll
    for (int ks = 0; ks < KS; ++ks) { const bf16x8 af = *(const LAS bf16x8*)(X + (xrow0 + l31) * px + 16 * ks + 8 * hi); const bf16x8 bfr = *(const LAS bf16x8*)(Y + (yrow0 + l31) * py + 16 * ks + 8 * hi);
        acc = __builtin_amdgcn_mfma_f32_32x32x16_bf16(af, bfr, acc, 0, 0, 0); }
}
template <int NV, bool FULL> __device__ __forceinline__ void scan_prep(const ScanLds& L, Raw& R, const bf16* P, const float* mu, int s0, int len, int pos0_next, bool has_next, int h, int dir, const ScanCh& ch, bool doG, int tid_, int wave, int lane_) {
    int tid = tid_, lane = lane_; asm volatile("" : "+v"(tid), "+v"(lane));
    __syncthreads();
    {
        const int t = tid >> 4, cq = (tid & 15) * 4;
        const LAS float* MU = L.MU;
        if (FULL) *(LAS f32x4*)(L.Rs + t * 64 + cq) = ts4_apply(R.q[0], MU, 0, cq);
        *(LAS f32x4*)(L.KRs + t * 64 + cq) = ts4_apply(R.q[1], MU, 1, cq);
        *(LAS f32x4*)(L.Vs + t * 64 + cq) = ts4_apply(R.q[2], MU, 2, cq);
        const f32x4 dw = ts4_apply(R.q[3], MU, 3, cq), da = ts4_apply(R.q[4], MU, 4, cq);
        v2u w; w.x = pk2(fast_tanh(dw.x), fast_tanh(dw.y)); w.y = pk2(fast_tanh(dw.z), fast_tanh(dw.w)); *(LAS v2u*)(L.DWb + t * 72 + cq) = w;
        v2u x; x.x = pk2(da.x, da.y); x.y = pk2(da.z, da.w); *(LAS v2u*)(L.DAb + t * 72 + cq) = x;
        if (doG) { const int c8 = (tid & 15) * 8; const f32x4 g0 = ts4_apply(R.g[0], MU, 5 + (c8 >> 6), c8 & 63), g1 = ts4_apply(R.g[1], MU, 5 + (c8 >> 6), (c8 & 63) + 4);
            v4u gq; gq.x = pk2(fast_sigmoid(g0.x), fast_sigmoid(g0.y)); gq.y = pk2(fast_sigmoid(g0.z), fast_sigmoid(g0.w)); gq.z = pk2(fast_sigmoid(g1.x), fast_sigmoid(g1.y)); gq.w = pk2(fast_sigmoid(g1.z), fast_sigmoid(g1.w));
            *(LAS v4u*)(L.DGb + t * 136 + c8) = gq; }
        if (has_next) raw_load<FULL>(R, P, s0, len, pos0_next, h, dir, doG, tid);
    }
    __syncthreads();
    const int l15 = lane & 15, lq = lane >> 4, th = wave >> 2, cqw = wave & 3, c = 16 * cqw + l15, tg = 4 * th + lq, t0 = 4 * tg;
    LAS float* PK = L.LWs; LAS float* PSB = L.LWs + 128;
    f32x4 alw = {0.f, 0.f, 0.f, 0.f}, ala = {0.f, 0.f, 0.f, 0.f};
#pragma unroll
    for (int ks = 0; ks < 2; ++ks) {
        const bf16x8 aw = *(const LAS bf16x8*)(L.DWb + (16 * th + l15) * 72 + 32 * ks + 8 * lq), bw = *(const LAS bf16x8*)(L.W2t + c * 72 + 32 * ks + 8 * lq);
        const bf16x8 aa = *(const LAS bf16x8*)(L.DAb + (16 * th + l15) * 72 + 32 * ks + 8 * lq), ba = *(const LAS bf16x8*)(L.A2t + c * 72 + 32 * ks + 8 * lq);
        alw = __builtin_amdgcn_mfma_f32_16x16x32_bf16(aw, bw, alw, 0, 0, 0); ala = __builtin_amdgcn_mfma_f32_16x16x32_bf16(aa, ba, ala, 0, 0, 0); }
    if (doG) { f32x4 ag = {0.f, 0.f, 0.f, 0.f};
#pragma unroll
        for (int ks = 0; ks < 4; ++ks) { const bf16x8 ga = *(const LAS bf16x8*)(L.DGb + (16 * th + l15) * 136 + 32 * ks + 8 * lq), gb = *(const LAS bf16x8*)(L.G2t + c * 136 + 32 * ks + 8 * lq);
            ag = __builtin_amdgcn_mfma_f32_16x16x32_bf16(ga, gb, ag, 0, 0, 0); }
#pragma unroll
        for (int r = 0; r < 4; ++r) L.GVb[(t0 + r) * 64 + c] = (bf16)f2bf(ag[r]); }
    float ld[4], kkr[4], av4[4], kd[4], rr[4], vv[4];
#pragma unroll
    for (int r = 0; r < 4; ++r) { const int t = t0 + r;
        ld[r] = -0.8750387749f * fast_sigmoid(alw[r] + ch.w0v);
        av4[r] = fast_sigmoid(ala[r] + ch.a0v);
        const float kraw = L.KRs[t * 64 + c]; kkr[r] = kraw * ch.kkw; kd[r] = kraw * (1.f + (av4[r] - 1.f) * ch.kaw);
        rr[r] = FULL ? L.Rs[t * 64 + c] : 0.f; vv[r] = L.Vs[t * 64 + c];
        const float pk = red16(kkr[r] * kkr[r]); if (l15 == 0) PK[t * 4 + cqw] = pk;
        if (FULL) { const float ps = red16(rr[r] * kd[r] * ch.rkw); if (l15 == 0) PSB[t * 4 + cqw] = ps; } }
    float pl[4]; pl[0] = ld[0]; pl[1] = pl[0] + ld[1]; pl[2] = pl[1] + ld[2]; pl[3] = pl[2] + ld[3];
    L.WT[tg * 64 + c] = pl[3];
    __syncthreads();
    float off = 0.f, tot = 0.f;
#pragma unroll
    for (int w = 0; w < 8; ++w) { const float x = L.WT[w * 64 + c]; tot += x; if (w < tg) off += x; }
    const float etot = __builtin_amdgcn_exp2f(tot);
    if (tg == 0) L.Wend[c] = etot;
    float khv[4], bhv[4]; float e_last = __builtin_amdgcn_exp2f(off);
#pragma unroll
    for (int r = 0; r < 4; ++r) { const int t = t0 + r; const float Lc = off + pl[r];
        const f32x4 p4 = *(const LAS f32x4*)(PK + t * 4); const float kk = kkr[r] * rsqrtf(fmaxf((p4.x + p4.y) + (p4.z + p4.w), 1e-24f)); const float bd = kk * av4[r];
        if (FULL && cqw == 0 && l15 == 0) { const f32x4 s4 = *(const LAS f32x4*)(PSB + t * 4); L.SBs[t] = (s4.x + s4.y) + (s4.z + s4.w); }
        const float e_in = __builtin_amdgcn_exp2f(Lc), e_prev = e_last, e_inv = __builtin_amdgcn_rcpf(e_in), e_end = etot * e_inv; e_last = e_in;
        L.Kap[t * 72 + c] = (bf16)f2bf(kk * e_prev); if (FULL) L.Rt[t * 72 + c] = (bf16)f2bf(rr[r] * e_in);
        L.Kt[t * 72 + c] = (bf16)f2bf(kd[r] * e_inv); L.Bt[t * 72 + c] = (bf16)f2bf(bd * e_inv);
        khv[r] = kd[r] * e_end; bhv[r] = -bd * e_end; }
    { v2u w; w.x = pk2(khv[0], khv[1]); w.y = pk2(khv[2], khv[3]); *(LAS v2u*)(L.Kh + c * 40 + t0) = w;
      v2u x; x.x = pk2(bhv[0], bhv[1]); x.y = pk2(bhv[2], bhv[3]); *(LAS v2u*)(L.Bh + c * 40 + t0) = x;
      v2u y; y.x = pk2(vv[0], vv[1]); y.y = pk2(vv[2], vv[3]); *(LAS v2u*)(L.Vt + c * 40 + t0) = y; }
    __syncthreads();
}
__device__ __forceinline__ void nat_store(LAS bf16* buf, const f32x16& d, int l31, int hi) {
#pragma unroll
    for (int g = 0; g < 4; ++g) { v2u w; w.x = pk2(d[4 * g], d[4 * g + 1]); w.y = pk2(d[4 * g + 2], d[4 * g + 3]); *(LAS v2u*)(buf + l31 * 40 + 8 * g + 4 * hi) = w; }
}
template <int NV, bool WITHY> __device__ __forceinline__ void scan_chunk(const ScanLds& L, f32x16& st, bool hasT, int kt, int vt, int wave, int lane_, bf16* ypark = nullptr) {
    int lane = lane_; asm volatile("" : "+v"(lane));
    const int l31 = lane & 31, hi = lane >> 5;
    const int utile = (wave >= 1 && wave <= NV / 32) ? wave - 1 : -1;
    f32x16 Q, QT, W;
    if (hasT) {
#pragma unroll
        for (int g = 0; g < 4; ++g) { v2u w; w.x = pk2(st[4 * g], st[4 * g + 1]); w.y = pk2(st[4 * g + 2], st[4 * g + 3]); *(LAS v2u*)(L.S16 + (32 * vt + l31) * 72 + 32 * kt + 8 * g + 4 * hi) = w; }
    }
    if (wave == 0) {
#pragma unroll
        for (int r = 0; r < 16; ++r) { Q[r] = 0.f; QT[r] = 0.f; }
        mm32<4>(Q, L.Bt, 72, 0, L.Kap, 72, 0, l31, hi);
        mm32<4>(QT, L.Kap, 72, 0, L.Bt, 72, 0, l31, hi);
#pragma unroll
        for (int r = 0; r < 16; ++r) { const int row = mrow(r, hi); Q[r] = row < l31 ? Q[r] : 0.f; QT[r] = l31 < row ? QT[r] : 0.f; W[r] = (row == l31 ? 1.f : 0.f) - QT[r]; }
        nat_store(L.BQ, Q, l31, hi); nat_store(L.BQT, QT, l31, hi);
        {   f32x16 Qn, QTn;
#pragma unroll
            for (int r = 0; r < 16; ++r) { Qn[r] = 0.f; QTn[r] = 0.f; }
            mm32<2>(Qn, L.BQT, 40, 0, L.BQ, 40, 0, l31, hi); mm32<2>(QTn, L.BQ, 40, 0, L.BQT, 40, 0, l31, hi); Q = Qn; QT = QTn; }
#pragma unroll
        for (int n = 1; n < 3; ++n) {
            nat_store(L.BQ, Q, l31, hi); nat_store(L.BQT, QT, l31, hi); nat_store(L.BW, W, l31, hi);
            f32x16 Qn, QTn;
#pragma unroll
            for (int r = 0; r < 16; ++r) { Qn[r] = 0.f; QTn[r] = 0.f; }
            mm32<2>(W, L.BQ, 40, 0, L.BW, 40, 0, l31, hi); mm32<2>(Qn, L.BQT, 40, 0, L.BQ, 40, 0, l31, hi); mm32<2>(QTn, L.BQ, 40, 0, L.BQT, 40, 0, l31, hi); Q = Qn; QT = QTn; }
    } else if (wave == 1) {
        f32x16 acc;
#pragma unroll
        for (int r = 0; r < 16; ++r) acc[r] = 0.f;
        mm32<4>(acc, L.Kt, 72, 0, L.Kap, 72, 0, l31, hi);
#pragma unroll
        for (int r = 0; r < 16; ++r) acc[r] = mrow(r, hi) < l31 ? acc[r] : 0.f;
        nat_store(L.Akk, acc, l31, hi);
    } else if (WITHY && (wave == 2 || wave == 3)) {
        f32x16 acc;
#pragma unroll
        for (int r = 0; r < 16; ++r) acc[r] = 0.f;
        mm32<4>(acc, wave == 2 ? L.Kt : L.Bt, 72, 0, L.Rt, 72, 0, l31, hi);
        const float sg = wave == 3 ? -1.f : 1.f;
#pragma unroll
        for (int r = 0; r < 16; ++r) acc[r] = mrow(r, hi) <= l31 ? sg * acc[r] : 0.f;
        nat_store(wave == 2 ? L.Akr : L.Abr, acc, l31, hi);
    }
    __syncthreads();
    f32x16 accy;
#pragma unroll
    for (int r = 0; r < 16; ++r) accy[r] = 0.f;
    if (utile >= 0) {
        f32x16 acc;
#pragma unroll
        for (int r = 0; r < 16; ++r) acc[r] = 0.f;
        mm32<4>(acc, L.Kap, 72, 0, L.S16, 72, 32 * utile, l31, hi);
        if (utile < 2) mm32<2>(acc, L.Akk, 40, 0, L.Vt, 40, 32 * utile, l31, hi);
        nat_store(L.U0b + 32 * utile * 40, acc, l31, hi);
        if (WITHY) { mm32<4>(accy, L.Rt, 72, 0, L.S16, 72, 32 * utile, l31, hi); mm32<2>(accy, L.Akr, 40, 0, L.Vt, 40, 32 * utile, l31, hi); }
    }
    if (wave == 0) {
#pragma unroll
        for (int n = 3; n < 5; ++n) {
            nat_store(L.BQ, Q, l31, hi); if (n < 4) nat_store(L.BQT, QT, l31, hi); nat_store(L.BW, W, l31, hi);
            f32x16 Qn, QTn;
#pragma unroll
            for (int r = 0; r < 16; ++r) { Qn[r] = 0.f; QTn[r] = 0.f; }
            mm32<2>(W, L.BQ, 40, 0, L.BW, 40, 0, l31, hi);
            if (n < 4) { mm32<2>(Qn, L.BQT, 40, 0, L.BQ, 40, 0, l31, hi); mm32<2>(QTn, L.BQ, 40, 0, L.BQT, 40, 0, l31, hi); Q = Qn; QT = QTn; } }
#pragma unroll
        for (int r = 0; r < 16; ++r) L.TiT[mrow(r, hi) * 40 + l31] = (bf16)f2bf(W[r]);
    }
    if (hasT) {
#pragma unroll
        for (int r = 0; r < 16; ++r) st[r] *= L.Wend[32 * kt + mrow(r, hi)];
        if (vt < 2) mm32<2>(st, L.Kh, 40, 32 * kt, L.Vt, 40, 32 * vt, l31, hi);
    }
    __syncthreads();
    if (utile >= 0) {
        f32x16 acc;
#pragma unroll
        for (int r = 0; r < 16; ++r) acc[r] = 0.f;
        mm32<2>(acc, L.TiT, 40, 0, L.U0b, 40, 32 * utile, l31, hi);
        nat_store(L.Ub + 32 * utile * 40, acc, l31, hi);
    }
    __syncthreads();
    if (WITHY && utile >= 0) {
        mm32<2>(accy, L.Abr, 40, 0, L.Ub, 40, 32 * utile, l31, hi);
        if (ypark) {
#pragma unroll
            for (int r = 0; r < 16; ++r) ypark[(size_t)mrow(r, hi) * 1024 + 32 * utile + l31] = (bf16)f2bf(accy[r]);
        } else {
#pragma unroll
            for (int r = 0; r < 16; ++r) L.Ys[mrow(r, hi) * 64 + 32 * utile + l31] = accy[r];
        }
    }
    if (hasT) mm32<2>(st, L.Bh, 40, 32 * kt, L.Ub, 40, 32 * vt, l31, hi);
}
__device__ __forceinline__ void scan_load_lora(const ScanLds& L, const Args& a, int l, int dir, int h, int tid) {
    __syncthreads();
    const bf16* LW = (const bf16*)(a.ws + WS_LORA) + (size_t)(dir * 8 + h) * 4096; const bf16* LA = LW + 65536;
    const int c = tid >> 3, part = (tid & 7) * 8;
    *(LAS v4u*)(L.W2t + c * 72 + part) = *(const v4u*)(LW + c * 64 + part); *(LAS v4u*)(L.A2t + c * 72 + part) = *(const v4u*)(LA + c * 64 + part);
    const float* mu = a.in[13] + (size_t)l * 2 * 1920;
    for (int e = tid; e < 1344; e += NTHR) { const int grp = e / 192, which = (e >> 6) % 3, col = e & 63;
        const int jb = grp == 0 ? h * 64 : grp == 1 ? 512 + h * 64 : grp == 2 ? 1024 + h * 64 : grp == 3 ? 1536 + dir * 64 : grp == 4 ? 1664 + dir * 64 : 1792 + (grp - 5) * 64;
        L.MU[e] = which < 2 ? mu[which * 1920 + jb + col] : 1.f - mu[jb + col] - mu[1920 + jb + col]; }
}
__device__ __forceinline__ void scan_load_g2(const ScanLds& L, const Args& a, int h, int tid) {
    const bf16* LG = (const bf16*)(a.ws + WS_LORA) + 131072 + (size_t)h * 8192;
#pragma unroll
    for (int q = 0; q < 2; ++q) { const int e = tid + q * NTHR; const int c = e >> 4, part = (e & 15) * 8; *(LAS v4u*)(L.G2t + c * 136 + part) = *(const v4u*)(LG + c * 128 + part); }
}
__device__ __forceinline__ ScanCh scan_ch(const Args& a, int l, int dir, int hc) {
    ScanCh c; c.kkw = a.in[19][l * 512 + hc]; c.kaw = a.in[20][l * 512 + hc]; c.rkw = a.in[21][l * 512 + hc]; c.w0v = a.in[14][(l * 2 + dir) * 512 + hc]; c.a0v = a.in[16][(l * 2 + dir) * 512 + hc]; return c;
}
__device__ __forceinline__ int seg_len(int b) { return b == 16 ? 512 : 1024; }
__device__ __forceinline__ int scan_item_of(int b, int h, int dir, int s) { const int hd = h * 2 + dir; return b == 16 ? hd * 32 + s : 512 + (b * 16 + hd) * 2 + s; }

template <int NV> __device__ __forceinline__ void scan_pass1(LAS unsigned char* lds, const Args& a, int l, int it, int tid, int wave, int lane) {
    int b, h, dir, s;
    if (NV == 64) { b = it >> 4; const int hd = it & 15; h = hd >> 1; dir = hd & 1; s = 0; }
    else { const int j = it - 256; const int hd = j / 31; s = j - hd * 31; b = 16; h = hd >> 1; dir = hd & 1; }
    const int s0 = b < 16 ? b * 2048 : 32768, len = b < 16 ? 2048 : 16384, SEGL = NV == 64 ? 1024 : 512;
    const bf16* P = (const bf16*)(a.ws + WS_P); const float* mu = a.in[13] + (size_t)l * 2 * 1920;
    const ScanLds L = scan_lds<NV>(lds); const ScanCh ch = scan_ch(a, l, dir, h * 64 + 16 * (wave & 3) + (lane & 15));
    Raw R; raw_load<false>(R, P, s0, len, dir ? len - 32 - s * SEGL : s * SEGL, h, dir, false, tid);
    scan_load_lora(L, a, l, dir, h, tid);
    if (NV == 128) { for (int e = tid; e < 64 * 20; e += NTHR) ((LAS unsigned*)(L.Vt + 64 * 40))[e] = 0u; }
    const int l31 = lane & 31, hi = lane >> 5, kt = wave & 1, vt = NV == 128 ? (wave >> 1) : ((wave >> 1) & 1); const bool hasT = NV == 128 ? true : wave >= 4;
    f32x16 st;
#pragma unroll
    for (int r = 0; r < 16; ++r) st[r] = (NV == 128 && (32 * vt + l31 - 64 == 32 * kt + mrow(r, hi))) ? 1.f : 0.f;
    for (int bt = 0; bt < SEGL / 32; ++bt) {
        const int n1 = s * SEGL + 32 * (bt + 1); const int pos1 = dir ? len - 32 - n1 : n1;
        scan_prep<NV, false>(L, R, P, mu, s0, len, pos1, bt + 1 < SEGL / 32, h, dir, ch, false, tid, wave, lane);
        scan_chunk<NV, false>(L, st, hasT, kt, vt, wave, lane);
    }
    float* AB = (float*)(a.ws + WS_AB) + (size_t)scan_item_of(b, h, dir, s) * 8192;
    if (hasT) { const int v = 32 * vt + l31; float* dst = v >= 64 ? AB + (v - 64) * 64 : AB + 4096 + v * 64;
#pragma unroll
      for (int g = 0; g < 4; ++g) *(f32x4*)(dst + 32 * kt + 8 * g + 4 * hi) = (f32x4){st[4 * g], st[4 * g + 1], st[4 * g + 2], st[4 * g + 3]}; }
    __syncthreads();
}
__device__ __forceinline__ void scan_pass2(LAS unsigned char* lds, const Args& a, int id, int tid) {
    int b, hd; if (id < 16) { b = 16; hd = id; } else { b = (id - 16) >> 4; hd = (id - 16) & 15; }
    const int v = tid >> 3, kq = (tid & 7) * 8;
    if (b < 16) {
        float* AB = (float*)(a.ws + WS_AB) + (size_t)(512 + (b * 16 + hd) * 2) * 8192;
        const f32x4 c0 = *(const f32x4*)(AB + 4096 + v * 64 + kq), c1 = *(const f32x4*)(AB + 4096 + v * 64 + kq + 4);
        *(f32x4*)(AB + 8192 + 4096 + v * 64 + kq) = c0; *(f32x4*)(AB + 8192 + 4096 + v * 64 + kq + 4) = c1;
        *(f32x4*)(AB + 4096 + v * 64 + kq) = (f32x4){0.f, 0.f, 0.f, 0.f}; *(f32x4*)(AB + 4096 + v * 64 + kq + 4) = (f32x4){0.f, 0.f, 0.f, 0.f};
        return;
    }
    const int nseg = 32; const int it0 = hd * 32;
    LAS float* Sm = (LAS float*)lds;
    LAS float* Am = (LAS float*)(lds + 32768);
    const int wave = tid >> 6, lane = tid & 63, l31 = lane & 31, hi = lane >> 5, vtl = (wave >> 1) & 1, ktl = wave & 1;
    __syncthreads();
    for (int e = tid; e < 64 * 65; e += NTHR) Sm[e] = 0.f;
    for (int s = 0; s < nseg; ++s) {
        float* AB = (float*)(a.ws + WS_AB) + (size_t)(it0 + s) * 8192;
        __syncthreads();
        if (s == nseg - 1) { *(f32x4*)(AB + 4096 + v * 64 + kq) = (f32x4){Sm[v * 65 + kq], Sm[v * 65 + kq + 1], Sm[v * 65 + kq + 2], Sm[v * 65 + kq + 3]};
                             *(f32x4*)(AB + 4096 + v * 64 + kq + 4) = (f32x4){Sm[v * 65 + kq + 4], Sm[v * 65 + kq + 5], Sm[v * 65 + kq + 6], Sm[v * 65 + kq + 7]}; break; }
        { const f32x4 a0 = *(const f32x4*)(AB + tid * 8), a1 = *(const f32x4*)(AB + tid * 8 + 4); *(LAS f32x4*)(Am + tid * 8) = a0; *(LAS f32x4*)(Am + tid * 8 + 4) = a1; }
        f32x16 acc;
        if (wave < 4) {
#pragma unroll
            for (int r = 0; r < 16; ++r) acc[r] = AB[4096 + (32 * vtl + mrow(r, hi)) * 64 + 32 * ktl + l31];
        }
        __syncthreads();
        *(f32x4*)(AB + 4096 + v * 64 + kq) = (f32x4){Sm[v * 65 + kq], Sm[v * 65 + kq + 1], Sm[v * 65 + kq + 2], Sm[v * 65 + kq + 3]};
        *(f32x4*)(AB + 4096 + v * 64 + kq + 4) = (f32x4){Sm[v * 65 + kq + 4], Sm[v * 65 + kq + 5], Sm[v * 65 + kq + 6], Sm[v * 65 + kq + 7]};
        if (wave < 4) {
#pragma unroll 8
            for (int ks = 0; ks < 32; ++ks) acc = __builtin_amdgcn_mfma_f32_32x32x2f32(Sm[(32 * vtl + l31) * 65 + 2 * ks + hi], Am[(2 * ks + hi) * 64 + 32 * ktl + l31], acc, 0, 0, 0);
        }
        __syncthreads();
        if (wave < 4) {
#pragma unroll
            for (int r = 0; r < 16; ++r) Sm[(32 * vtl + mrow(r, hi)) * 65 + 32 * ktl + l31] = acc[r];
        }
    }
    __syncthreads();
}
__device__ __forceinline__ void scan_pass3(LAS unsigned char* lds, const Args& a, int l, int it, int tid, int wave, int lane) {
    int b, h, ts; if (it < 256) { ts = it & 1; h = (it >> 1) & 7; b = it >> 4; } else { const int j = it - 256; b = 16; ts = j & 31; h = j >> 5; }
    const int s0 = b < 16 ? b * 2048 : 32768, len = b < 16 ? 2048 : 16384, SEG = seg_len(b), nseg = len / SEG;
    const bf16* P = (const bf16*)(a.ws + WS_P); bf16* Y = (bf16*)(a.ws + WS_XN); const float* mu = a.in[13] + (size_t)l * 2 * 1920;
    const ScanLds L = scan_lds<64>(lds);
    const int hc = h * 64 + lane;
    const float lxw = a.in[22][l * 512 + hc], lxb = a.in[23][l * 512 + hc];
    __syncthreads();
    scan_load_g2(L, a, h, tid);
    const int l31 = lane & 31, hi = lane >> 5, kt = wave & 1, vt = (wave >> 1) & 1; const bool hasT = wave >= 4;
    float* SB0 = (float*)(a.ws + WS_SB);
    for (int dir = 0; dir < 2; ++dir) {
        const ScanCh ch = scan_ch(a, l, dir, h * 64 + 16 * (wave & 3) + (lane & 15));
        const int s = dir ? nseg - 1 - ts : ts;
        Raw R; raw_load<true>(R, P, s0, len, dir ? len - 32 - s * SEG : s * SEG, h, dir, dir == 1, tid);
        scan_load_lora(L, a, l, dir, h, tid);
        const float* Sst = (const float*)(a.ws + WS_AB) + (size_t)scan_item_of(b, h, dir, s) * 8192 + 4096;
        f32x16 st;
#pragma unroll
        for (int g = 0; g < 4; ++g) { const f32x4 x = *(const f32x4*)(Sst + (32 * vt + l31) * 64 + 32 * kt + 8 * g + 4 * hi); st[4 * g] = x.x; st[4 * g + 1] = x.y; st[4 * g + 2] = x.z; st[4 * g + 3] = x.w; }
        for (int bt = 0; bt < SEG / 32; ++bt) {
            const int n0 = s * SEG + 32 * bt; const int pos0 = dir ? len - 32 - n0 : n0;
            const int n1 = n0 + 32; const int pos1 = dir ? len - 32 - n1 : n1;
            scan_prep<64, true>(L, R, P, mu, s0, len, pos1, bt + 1 < SEG / 32, h, dir, ch, dir == 1, tid, wave, lane);
            if (dir == 0) {
                scan_chunk<64, true>(L, st, hasT, kt, vt, wave, lane, Y + (size_t)(s0 + pos0) * 1024 + 512 + h * 64);
                if (tid < 32) SB0[(size_t)(s0 + pos0 + tid) * 8 + h] = L.SBs[tid];
            } else {
                float ypk[4], sbp[4];
#pragma unroll
                for (int tt = 0; tt < 4; ++tt) { const size_t row = (size_t)(s0 + pos0 + 31 - (wave * 4 + tt)); ypk[tt] = ldbf(Y + row * 1024 + 512 + hc); sbp[tt] = SB0[row * 8 + h]; }
                scan_chunk<64, true>(L, st, hasT, kt, vt, wave, lane);
                __syncthreads();
#pragma unroll
                for (int tt = 0; tt < 4; ++tt) { const int t = wave * 4 + tt; const size_t row = (size_t)(s0 + pos0 + 31 - t);
                    const float y = L.Ys[t * 64 + lane] + ypk[tt];
                    const float m = wave_sum(y) * (1.f / 64.f); const float d = y - m; const float var = wave_sum(d * d) * (1.f / 64.f);
                    const float yn = d * rsqrtf(var + GN_EPS_F) * lxw + lxb;
                    const float bonus = (L.SBs[t] + sbp[tt]) * L.Vs[t * 64 + lane];
                    Y[row * 1024 + 512 + hc] = (bf16)f2bf((yn + bonus) * bf2f((unsigned)L.GVb[t * 64 + lane])); }
            }
        }
        __threadfence();
    }
    __syncthreads();
}

#define XB_TMO      128
#define XB_XCNT(j)  (256  + 64 * (j))
#define XB_XSUB(j)  (1280 + 64 * (j))
#define XB_XGEN(j)  (2304 + 64 * (j))
#define XB_TOP      3328
#define XB_TOPGEN   3392
#define XCD_BAR_WORDS 3456
#define XB_SPIN_CAP (1u << 22)

__device__ __forceinline__ unsigned xb_ld(unsigned* p)              { return __hip_atomic_load(p, __ATOMIC_RELAXED, __HIP_MEMORY_SCOPE_AGENT); }
__device__ __forceinline__ unsigned xb_add(unsigned* p, unsigned v) { return __hip_atomic_fetch_add(p, v, __ATOMIC_RELAXED, __HIP_MEMORY_SCOPE_AGENT); }
__device__ __forceinline__ unsigned xb_xcc_id() { return (unsigned)__builtin_amdgcn_s_getreg((3 << 11) | 20) & 0xFu; }
#define XB_SPIN(cond, bar) do { unsigned _sp = 0; while (cond) { __builtin_amdgcn_s_sleep(1); \
    if ((++_sp & 255u) == 0u) { if (xb_ld(&(bar)[XB_TMO])) break; if (_sp > XB_SPIN_CAP) { atomicAdd(&(bar)[XB_TMO], 1u); break; } } } } while (0)

struct XcdBarrier {
    unsigned* bar; unsigned x;
    volatile LAS unsigned* st;
};

__device__ __forceinline__ XcdBarrier xcd_barrier_post(unsigned* bar, volatile LAS unsigned* st) {
    XcdBarrier b; b.bar = bar; b.x = xb_xcc_id(); b.st = st;
    if (threadIdx.x == 0) (void)xb_add(&bar[XB_XCNT(b.x)], 1u);
    return b;
}
__device__ __forceinline__ void xcd_barrier_complete(unsigned* bar, unsigned x, unsigned& nloc, unsigned& nx) {
    const unsigned G = gridDim.x * gridDim.y * gridDim.z;
    unsigned sum, cnt, mine, sp = 0u;
    for (;;) {
        sum = 0u; cnt = 0u; mine = 0u;
#pragma unroll
        for (unsigned j = 0; j < 16; ++j) { const unsigned c = xb_ld(&bar[XB_XCNT(j)]); sum += c; cnt += (c > 0u) ? 1u : 0u; mine = (j == x) ? c : mine; }
        if (sum == G) break;
        __builtin_amdgcn_s_sleep(1);
        if ((++sp & 255u) == 0u) { if (xb_ld(&bar[XB_TMO])) break; if (sp > XB_SPIN_CAP) { atomicAdd(&bar[XB_TMO], 1u); break; } }
    }
    nloc = mine > 0u ? mine : 1u; nx = cnt > 0u ? cnt : 1u;
}

__device__ __forceinline__ void xcd_barrier(const XcdBarrier& b) {
    asm volatile("s_waitcnt vmcnt(0)" ::: "memory");
    __syncthreads();
    if (threadIdx.x == 0) {
        unsigned* bar = b.bar;
        __builtin_amdgcn_s_waitcnt(0);
        unsigned nloc = b.st[0], nx = b.st[1];
        if (nloc == 0u) { xcd_barrier_complete(bar, b.x, nloc, nx); b.st[0] = nloc; b.st[1] = nx; }
        const unsigned old = xb_add(&bar[XB_XSUB(b.x)], 1u);
        const unsigned gen = old / nloc;
        if (old + 1u == (gen + 1u) * nloc) {
            __builtin_amdgcn_fence(__ATOMIC_RELEASE, "agent");
            asm volatile("s_waitcnt vmcnt(0)" ::: "memory");
            const unsigned og = xb_add(&bar[XB_TOP], 1u);
            const unsigned tg = og / nx;
            if (og + 1u == (tg + 1u) * nx) xb_add(&bar[XB_TOPGEN], 1u);
            else XB_SPIN(xb_ld(&bar[XB_TOPGEN]) == tg, bar);
            __builtin_amdgcn_fence(__ATOMIC_ACQUIRE, "agent");
            xb_add(&bar[XB_XGEN(b.x)], 1u);
            asm volatile("s_waitcnt vmcnt(0)" ::: "memory");
        } else {
            XB_SPIN(xb_ld(&bar[XB_XGEN(b.x)]) == gen, bar);
            __builtin_amdgcn_fence(__ATOMIC_ACQUIRE, "agent");
            asm volatile("s_waitcnt vmcnt(0)" ::: "memory");
        }
    }
    __syncthreads();
}

#ifndef G1_ON
#define G1_ON 1
#endif
#ifndef G2_ON
#define G2_ON 1
#endif
#ifndef G3_ON
#define G3_ON 1
#endif
#ifndef G4_ON
#define G4_ON 1
#endif
#if defined(__HIP_DEVICE_COMPILE__)
#define LOAD_ARGS() const __attribute__((address_space(4))) unsigned char* kp_ = (const __attribute__((address_space(4))) unsigned char*)__builtin_amdgcn_kernarg_segment_ptr(); asm volatile("" : "+s"(kp_)); const Args a = *(const __attribute__((address_space(4))) Args*)kp_
#else
#define LOAD_ARGS() const Args a = a0
#endif
template <bool COOP>
__global__ void __launch_bounds__(NTHR, 2) fwd_kernel(Args a0) {
    extern __shared__ __attribute__((aligned(16))) unsigned char lds_raw[];
    LAS unsigned char* lds = (LAS unsigned char*)lds_raw;
    const int G = gridDim.x, NGW = G * NWAVES;
    const int wave0 = __builtin_amdgcn_readfirstlane((int)threadIdx.x >> 6);
#define TIDS() int lane_ = (int)__builtin_amdgcn_mbcnt_hi(~0u, __builtin_amdgcn_mbcnt_lo(~0u, 0u)); asm volatile("" : "+v"(lane_)); const int lane = lane_, wave = wave0, tid = wave0 * 64 + lane, gw = blockIdx.x * NWAVES + wave; (void)gw; (void)lane; (void)tid; LOAD_ARGS()
    cg::grid_group grid = cg::this_grid();
    const int ph_lo = a0.ph_lo, ph_hi = a0.ph_hi;
#define RUN(k) (ph_lo <= (k) && (k) < ph_hi)
    XcdBarrier xbar; xbar.bar = (unsigned*)a0.ws; xbar.x = 0; xbar.st = (volatile LAS unsigned*)(lds + 147392);
    if (COOP) { if (threadIdx.x == 0) { xbar.st[0] = 0u; xbar.st[1] = 0u; } __syncthreads(); xbar = xcd_barrier_post((unsigned*)a0.ws, (volatile LAS unsigned*)(lds + 147392)); }
#define SEAM(k) do { if (COOP) { if (RUN(k) && RUN((k) + 1)) { if ((k) == 0) grid.sync(); else xcd_barrier(xbar); } } } while (0)
#define P_X (a.out)
#define P_XN ((bf16*)(a.ws + WS_XN))
#define P_PB ((bf16*)(a.ws + WS_P))
#define P_MODL ((const float*)(a.ws + WS_MOD) + (size_t)l * 17 * NMOD)
#define P_XA (l == 0 ? a.in[0] : (const float*)a.out)
#define P_XB (l == 0 ? a.in[1] : (const float*)a.out + (size_t)32768 * 1024)
    if (RUN(0)) { TIDS(); mod_phase(a, lds, tid); }
    SEAM(0);
#pragma unroll 1
    for (int l = 0; l < NLAYER; ++l) {
        const int pb = 1 + 9 * l;
        if (RUN(pb + 0)) { TIDS(); convert_weights(a, l, lds, gw, NGW, wave, lane); norm_phase(P_XA, P_XB, a.in[6] + l * 1024, P_MODL, 0, 1024, P_XN, gw, NGW, lane); }
        SEAM(pb + 0);
        if (RUN(pb + 1)) { TIDS(); pg8::Gemm g{P_XN, (const bf16*)(a.ws + WS_WIN), MTOK, PLD, 1024}; pg8::StaticOrder S; S.init(MTOK, PLD, G, (int)blockIdx.x);
            pg8::EpiBf16 E{P_PB, PLD}; pg8::gemm_phase<pg8::EpiBf16, pg8::StaticOrder, true, true>(lds, g, S, E, tid); }
        SEAM(pb + 1);
        if (RUN(pb + 2)) { TIDS(); for (int it = blockIdx.x; it < 752; it += G) { if (it < 256) scan_pass1<64>(lds, a, l, it, tid, wave, lane); else scan_pass1<128>(lds, a, l, it, tid, wave, lane); } }
        SEAM(pb + 2);
        if (RUN(pb + 3)) { TIDS(); for (int id = 16 + blockIdx.x; id < 272; id += G) scan_pass2(lds, a, id, tid);
            if (G > 32) { if (blockIdx.x < 16) scan_pass2(lds, a, (int)blockIdx.x, tid); else for (int it = blockIdx.x - 16; it < 1536; it += G - 16) mixer_a_item(lds, a, l, it, tid, wave, lane); }
            else { for (int it = blockIdx.x; it < 16 + 1536; it += G) { if (it < 16) scan_pass2(lds, a, it, tid); else mixer_a_item(lds, a, l, it - 16, tid, wave, lane); } } }
        SEAM(pb + 3);
        if (RUN(pb + 4)) { TIDS(); for (int it = blockIdx.x; it < 512; it += G) scan_pass3(lds, a, l, it, tid, wave, lane); }
        SEAM(pb + 4);
        if (RUN(pb + 5)) { TIDS(); pg8::Gemm g{P_XN, (const bf16*)(a.ws + WS_WOUT), MTOK, 1024, 1024}; pg8::StaticOrder S; S.init(MTOK, 1024, G, (int)blockIdx.x);
            pg8::EpiRes E{P_XA, P_XB, P_X, P_MODL + 2048}; pg8::gemm_phase<pg8::EpiRes, pg8::StaticOrder, true, true>(lds, g, S, E, tid); }
        SEAM(pb + 5);
        if (RUN(pb + 6)) { TIDS(); norm_phase(P_X, P_X + (size_t)32768 * 1024, a.in[25] + l * 1024, P_MODL, 3072, 4096, P_XN, gw, NGW, lane); }
        SEAM(pb + 6);
        if (RUN(pb + 7)) { TIDS(); pg8::Gemm g{P_XN, (const bf16*)(a.ws + WS_WGU), MTOK, 5632, 1024}; pg8::StaticOrder S; S.init(MTOK, 5632, G, (int)blockIdx.x);
            pg8::EpiSwiGLU E{P_PB}; pg8::gemm_phase<pg8::EpiSwiGLU, pg8::StaticOrder, true, true>(lds, g, S, E, tid); }
        SEAM(pb + 7);
        if (RUN(pb + 8)) { TIDS(); pg8::Gemm g{P_PB, (const bf16*)(a.ws + WS_WDN), MTOK, 1024, DFF}; pg8::StaticOrder S; S.init(MTOK, 1024, G, (int)blockIdx.x);
            pg8::EpiRes E{P_X, P_X + (size_t)32768 * 1024, P_X, P_MODL + 5120}; pg8::gemm_phase<pg8::EpiRes, pg8::StaticOrder, true, true>(lds, g, S, E, tid); }
        SEAM(pb + 8);
    }
    if (RUN(37)) { TIDS(); final_norm_phase(P_X, a.in[28], gw, NGW, lane); }
#undef RUN
#undef SEAM
}
constexpr int N_PHASES = 38;
#ifndef MK_COOP
#define MK_COOP 1
#endif

extern "C" void kernel_launch(void* const* d_in, const int* in_sizes, int n_in, void* d_out, int out_size, void* d_ws, size_t ws_size, hipStream_t stream) {
    static int grid = 0;
    if (grid == 0) {
        if (n_in != 29 || out_size != MTOK * DM || ws_size < WS_END) { fprintf(stderr, "kernel_launch: unexpected shapes n_in %d out %d ws %zu (need %zu)\n", n_in, out_size, ws_size, (size_t)WS_END); grid = -1; return; }
        int dev = 0, cus = 0, per_cu = 0;
        hipGetDevice(&dev); hipDeviceGetAttribute(&cus, hipDeviceAttributeMultiprocessorCount, dev);
        hipFuncSetAttribute((const void*)fwd_kernel<true>, hipFuncAttributeMaxDynamicSharedMemorySize, LDS_BYTES);
        hipFuncSetAttribute((const void*)fwd_kernel<false>, hipFuncAttributeMaxDynamicSharedMemorySize, LDS_BYTES);
        hipOccupancyMaxActiveBlocksPerMultiprocessor(&per_cu, (const void*)fwd_kernel<true>, NTHR, LDS_BYTES);
        if (per_cu < 1) per_cu = 1;
        (void)hipGetLastError();
        grid = cus * per_cu;
    }
    if (grid < 0) return;
#if MK_COOP
    if (hipMemsetAsync(d_ws, 0, 16384, stream) != hipSuccess) { fprintf(stderr, "kernel_launch: memset of the barrier words failed\n"); return; }
#endif
    Args a{};
    for (int i = 0; i < 29; ++i) a.in[i] = (const float*)d_in[i];
    a.out = (float*)d_out; a.ws = (unsigned char*)d_ws;
#if MK_COOP
    a.ph_lo = 0; a.ph_hi = N_PHASES;
    void* args[] = {&a};
    hipError_t e = hipLaunchCooperativeKernel((const void*)fwd_kernel<true>, dim3(grid), dim3(NTHR), args, LDS_BYTES, stream);
    if (e != hipSuccess) fprintf(stderr, "cooperative launch failed: %s (grid %d)\n", hipGetErrorString(e), grid);
#else
    for (int p = 0; p < N_PHASES; ++p) { a.ph_lo = p; a.ph_hi = p + 1; hipLaunchKernelGGL(fwd_kernel<false>, dim3(grid), dim3(NTHR), LDS_BYTES, stream, a); }
#endif
}
```

```cpp
#include <hip/hip_runtime.h>
#include <hip/hip_cooperative_groups.h>
#include <cstdio>
#include <cstdint>
namespace cg = cooperative_groups;
namespace pg8 {
#define PG8_LAS __attribute__((address_space(3)))
typedef unsigned short bf16_t;
typedef short bf16x8 __attribute__((ext_vector_type(8)));
typedef float f32x4 __attribute__((ext_vector_type(4)));
typedef unsigned u32x4 __attribute__((ext_vector_type(4)));
constexpr int BM = 256, BK = 64, HALF = 128, HTB = HALF * BK * 2  , STAGE_BYTES = 8 * HTB, NXCD = 8, WGM = 4;

__host__ __device__ __forceinline__ int lds_byte(int r, int c) { const int st = (r >> 4) * 2 + (c >> 5), rr = r & 15, cc = c & 31, ob = rr * 64 + cc * 2; return st * 1024 + (ob ^ (((ob >> 9) & 1) << 5)); }
__host__ __device__ __forceinline__ void stage_rc(int b, int& R, int& C) { const int st = b / 1024, sb = b % 1024, swz = sb ^ (((sb >> 9) & 1) << 5); R = (st >> 1) * 16 + swz / 64; C = (st & 1) * 32 + (swz % 64) / 2; }
__host__ __device__ __forceinline__ int perm32(int rho) { const int n = rho >> 4, i = rho & 15; return 8 * (i >> 2) + 4 * n + (i & 3); }

struct Unit { int pm, pn; };
struct Gemm { const bf16_t* A; const bf16_t* Bt; int M, N, K; };

struct StaticOrder {
    int nM, nN, nwg, G, c;
    __host__ __device__ void init(int M, int N, int G_, int c_) { nM = M / BM; nN = N / BM; nwg = nM * nN; G = G_; c = c_; }
    __host__ __device__ bool next(int i, Unit& u) const {
        const long L = (long)i * G + c; if (L >= nwg) return false;
        int wgid = (int)L; { const int q = nwg / NXCD, r = nwg % NXCD, xcd = wgid % NXCD, off = wgid / NXCD; wgid = (xcd < r ? xcd * (q + 1) : r * (q + 1) + (xcd - r) * q) + off; }
        const int nig = WGM * nN, gid = wgid / nig, fm = gid * WGM, gsz = (nM - fm) < WGM ? (nM - fm) : WGM;
        u.pm = fm + ((wgid % nig) % gsz); u.pn = (wgid % nig) / gsz; return true;
    }
    __device__ __forceinline__ void a_ready(const Unit&) const {}
    __device__ __forceinline__ void done(const Unit&) const {}
};


typedef __bf16 bf16v2_t __attribute__((ext_vector_type(2)));
typedef float f32v2_t __attribute__((ext_vector_type(2)));
__device__ __forceinline__ unsigned cvt_pk_bf16(float lo, float hi) { const f32v2_t v = {lo, hi}; const bf16v2_t b = __builtin_convertvector(v, bf16v2_t); return __builtin_bit_cast(unsigned, b); }
__device__ __forceinline__ int batch_of_row(int row) { return row < 32768 ? (row >> 11) : 16; }

struct EpiBf16 {
    static constexpr bool PERM = true, AFTER_DRAIN = false;
    bf16_t* O; int ldc;
    __device__ __forceinline__ void operator()(const f32x4 (&acc)[2][2][4][2], const Unit& u, int wr, int wc, int fr, int fq) const {
        const int row0 = u.pm * BM + wr * 64 + fr; const int col0 = u.pn * BM + wc * 32 + 8 * fq;
#pragma unroll
        for (int ai = 0; ai < 2; ++ai)
#pragma unroll
            for (int m = 0; m < 4; ++m) { bf16_t* rowp = O + (size_t)(row0 + ai * HALF + m * 16) * ldc + col0;
#pragma unroll
                for (int bj = 0; bj < 2; ++bj) { const f32x4 v0 = acc[ai][bj][m][0], v1 = acc[ai][bj][m][1];
                    u32x4 w; w.x = cvt_pk_bf16(v0[0], v0[1]); w.y = cvt_pk_bf16(v0[2], v0[3]); w.z = cvt_pk_bf16(v1[0], v1[1]); w.w = cvt_pk_bf16(v1[2], v1[3]);
                    *(u32x4*)(rowp + bj * HALF) = w; } }
    }
};
__device__ __forceinline__ float silu_f(float g) { return g * __builtin_amdgcn_rcpf(1.f + __expf(-g)); }
struct EpiSwiGLU {
    static constexpr bool PERM = true, AFTER_DRAIN = false;
    bf16_t* O;
    __device__ __forceinline__ void operator()(const f32x4 (&acc)[2][2][4][2], const Unit& u, int wr, int wc, int fr, int fq) const {
        const int row0 = u.pm * BM + wr * 64 + fr; const int col0 = u.pn * 128 + wc * 32 + 8 * fq;
#pragma unroll
        for (int ai = 0; ai < 2; ++ai)
#pragma unroll
            for (int m = 0; m < 4; ++m) { bf16_t* rowp = O + (size_t)(row0 + ai * HALF + m * 16) * 2816 + col0;
                const f32x4 g0 = acc[ai][0][m][0], g1 = acc[ai][0][m][1], u0 = acc[ai][1][m][0], u1 = acc[ai][1][m][1];
                u32x4 w;
                w.x = cvt_pk_bf16(silu_f(g0[0]) * u0[0], silu_f(g0[1]) * u0[1]); w.y = cvt_pk_bf16(silu_f(g0[2]) * u0[2], silu_f(g0[3]) * u0[3]);
                w.z = cvt_pk_bf16(silu_f(g1[0]) * u1[0], silu_f(g1[1]) * u1[1]); w.w = cvt_pk_bf16(silu_f(g1[2]) * u1[2], silu_f(g1[3]) * u1[3]);
                *(u32x4*)rowp = w; }
    }
};
struct EpiRes {
    static constexpr bool PERM = false, AFTER_DRAIN = false;
    const float* base_a; const float* base_b; float* out; const float* gate;
    __device__ __forceinline__ void operator()(const f32x4 (&acc)[2][2][4][2], const Unit& u, int wr, int wc, int fr, int fq) const {
        const int row0 = u.pm * BM + wr * 64 + fr; const int b = batch_of_row(u.pm * BM); const int col0 = u.pn * BM + wc * 32 + 4 * fq;
        f32x4 gv[2][2];
#pragma unroll
        for (int bj = 0; bj < 2; ++bj)
#pragma unroll
            for (int n = 0; n < 2; ++n) gv[bj][n] = *(const f32x4*)(gate + (size_t)b * 6144 + col0 + bj * HALF + n * 16);
#pragma unroll
        for (int ai = 0; ai < 2; ++ai)
#pragma unroll
            for (int m = 0; m < 4; ++m) { const int row = row0 + ai * HALF + m * 16;
                const float* bp = row < 32768 ? base_a + (size_t)row * 1024 : base_b + (size_t)(row - 32768) * 1024; float* op = out + (size_t)row * 1024;
#pragma unroll
                for (int bj = 0; bj < 2; ++bj)
#pragma unroll
                    for (int n = 0; n < 2; ++n) { const int c = col0 + bj * HALF + n * 16; const f32x4 o = *(const f32x4*)(bp + c) + gv[bj][n] * acc[ai][bj][m][n]; *(f32x4*)(op + c) = o; }
                if (m & 1) asm volatile("" ::: "memory"); }
    }
};

template <class Epi, class Sched, bool ALIGN_EPI = false, bool SP2 = false>
__device__ __forceinline__ void gemm_phase(PG8_LAS unsigned char* lds, const Gemm g, const Sched& S, const Epi& E, int tid_in) {
    int tid_ = tid_in; asm volatile("" : "+v"(tid_)); const int tid = tid_, wid = __builtin_amdgcn_readfirstlane(tid >> 6), lane = tid & 63, wr = wid >> 2, wc = wid & 3, fr = lane & 15, fq = lane >> 4;
    const int K = g.K, nt = K / BK;
    unsigned voffA[2], voffB[2];
#pragma unroll
    for (int i = 0; i < 2; ++i) { int R, C; stage_rc(tid * 16 + i * 8192, R, C); const int Rb = Epi::PERM ? ((R & ~31) + perm32(R & 31)) : R;
        voffA[i] = (unsigned)(R * K + C) * 2u; voffB[i] = (unsigned)(Rb * K + C) * 2u; }
    const size_t kstep = (size_t)(BK * 2);
    const size_t hstep = (size_t)HALF * K * 2;
    const size_t tstep = 2 * hstep;
    const unsigned ldsw = (unsigned)wid * 1024u;
    const int aoff = lds_byte(wr * 64 + fr, fq * 8), boff = lds_byte(wc * 32 + fr, fq * 8);
#define PG8_SA(b, h) (((b) * 2 + (h)) * HTB)
#define PG8_SB(b, h) ((4 + (b) * 2 + (h)) * HTB)
#define PG8_STAGE(bufoff, gbase, voff) do { _Pragma("unroll") for (int _i = 0; _i < 2; ++_i) \
        __builtin_amdgcn_global_load_lds((const unsigned*)((const char*)(gbase) + (voff)[_i]), (PG8_LAS unsigned*)(lds + (bufoff) + ldsw + _i * 8192), 16, 0, 0); } while (0)
#define PG8_LDA(dst, b, h) do { _Pragma("unroll") for (int m = 0; m < 4; ++m) _Pragma("unroll") for (int k = 0; k < 2; ++k) dst[m][k] = *(const PG8_LAS bf16x8*)(lds + PG8_SA(b, h) + aoff + m * 2048 + k * 1024); } while (0)
#define PG8_LDB(dst, b, h) do { _Pragma("unroll") for (int n = 0; n < 2; ++n) _Pragma("unroll") for (int k = 0; k < 2; ++k) dst[n][k] = *(const PG8_LAS bf16x8*)(lds + PG8_SB(b, h) + boff + n * 2048 + k * 1024); } while (0)
#define PG8_MMA(ai, bj, At, Bt) do { __builtin_amdgcn_s_setprio(1); _Pragma("unroll") for (int m = 0; m < 4; ++m) _Pragma("unroll") for (int n = 0; n < 2; ++n) _Pragma("unroll") for (int k = 0; k < 2; ++k) \
        acc[ai][bj][m][n] = __builtin_amdgcn_mfma_f32_16x16x32_bf16(Bt[n][k], At[m][k], acc[ai][bj][m][n], 0, 0, 0); __builtin_amdgcn_s_setprio(0); } while (0)
#define PG8_WAIT_V(n) asm volatile("s_waitcnt vmcnt(" #n ")" ::: "memory")
#define PG8_WAIT_L(n) asm volatile("s_waitcnt lgkmcnt(" #n ")" ::: "memory")
#define PG8_BAR __builtin_amdgcn_s_barrier()
#define PG8_SCHED __builtin_amdgcn_sched_barrier(0)
    Unit cur, nxt; int ui = 0;
    if (!S.next(0, cur)) return;
    f32x4 acc[2][2][4][2];
#pragma unroll
    for (int a = 0; a < 2; ++a)
#pragma unroll
        for (int b = 0; b < 2; ++b)
#pragma unroll
            for (int m = 0; m < 4; ++m)
#pragma unroll
                for (int n = 0; n < 2; ++n) acc[a][b][m][n] = (f32x4){0.f, 0.f, 0.f, 0.f};
    bf16x8 At[4][2], B0[2][2], B1[2][2];
    const char* cA = (const char*)g.A + (size_t)cur.pm * tstep; const char* cB = (const char*)g.Bt + (size_t)cur.pn * tstep;
    S.a_ready(cur);
    if constexpr (SP2) {
        PG8_STAGE(PG8_SB(0, 0), cB, voffB); PG8_STAGE(PG8_SB(0, 1), cB + hstep, voffB); PG8_STAGE(PG8_SA(0, 0), cA, voffA); PG8_STAGE(PG8_SA(0, 1), cA + hstep, voffA);
        if (wr == 1) PG8_BAR;
        PG8_WAIT_V(2); PG8_BAR;
        PG8_STAGE(PG8_SB(1, 0), cB + kstep, voffB); PG8_STAGE(PG8_SA(1, 0), cA + kstep, voffA); PG8_STAGE(PG8_SB(1, 1), cB + hstep + kstep, voffB);
        PG8_WAIT_V(6); PG8_BAR;
    } else {
        PG8_STAGE(PG8_SB(0, 0), cB, voffB); PG8_STAGE(PG8_SA(0, 0), cA, voffA); PG8_STAGE(PG8_SB(0, 1), cB + hstep, voffB); PG8_STAGE(PG8_SA(0, 1), cA + hstep, voffA);
        if (wr == 1) PG8_BAR;
        PG8_WAIT_V(4); PG8_BAR;
        PG8_STAGE(PG8_SB(1, 0), cB + kstep, voffB); PG8_STAGE(PG8_SA(1, 0), cA + kstep, voffA); PG8_STAGE(PG8_SB(1, 1), cB + hstep + kstep, voffB);
        PG8_WAIT_V(6); PG8_BAR;
    }
    for (;;) {
        const bool has_next = S.next(ui + 1, nxt);
        const char* nA = has_next ? (const char*)g.A + (size_t)nxt.pm * tstep : cA; const char* nB = has_next ? (const char*)g.Bt + (size_t)nxt.pn * tstep : cB;
        for (int t = 0; t < nt; t += 2) {
            const bool last = (t == nt - 2);
            const char* a1 = cA + (size_t)(t + 1) * kstep;
            const char* a2 = last ? nA : cA + (size_t)(t + 2) * kstep; const char* b2 = last ? nB : cB + (size_t)(t + 2) * kstep;
            const char* a3 = a2 + kstep; const char* b3 = b2 + kstep;
            if (last && has_next) S.a_ready(nxt);
            if constexpr (SP2) {
            PG8_LDB(B0, 0, 0); PG8_LDB(B1, 0, 1); PG8_SCHED; PG8_LDA(At, 0, 0); PG8_STAGE(PG8_SA(1, 1), a1 + hstep, voffA);
            PG8_WAIT_V(8); PG8_WAIT_L(0); PG8_BAR; PG8_MMA(0, 0, At, B0); PG8_MMA(0, 1, At, B1); PG8_BAR; PG8_SCHED;
            PG8_LDA(At, 0, 1); PG8_STAGE(PG8_SB(0, 0), b2, voffB); PG8_STAGE(PG8_SB(0, 1), b2 + hstep, voffB); PG8_STAGE(PG8_SA(0, 0), a2, voffA);
            PG8_WAIT_V(8); PG8_WAIT_L(0); PG8_BAR; PG8_MMA(1, 0, At, B0); PG8_MMA(1, 1, At, B1); PG8_BAR; PG8_SCHED;
            PG8_LDB(B0, 1, 0); PG8_LDB(B1, 1, 1); PG8_SCHED; PG8_LDA(At, 1, 0); PG8_STAGE(PG8_SA(0, 1), a2 + hstep, voffA);
            PG8_WAIT_V(8); PG8_WAIT_L(0); PG8_BAR; PG8_MMA(0, 0, At, B0); PG8_MMA(0, 1, At, B1); PG8_BAR; PG8_SCHED;
            PG8_LDA(At, 1, 1); PG8_STAGE(PG8_SB(1, 0), b3, voffB); PG8_STAGE(PG8_SB(1, 1), b3 + hstep, voffB); PG8_STAGE(PG8_SA(1, 0), a3, voffA);
            PG8_WAIT_V(8); PG8_WAIT_L(0); PG8_BAR; PG8_MMA(1, 0, At, B0); PG8_MMA(1, 1, At, B1); PG8_BAR; PG8_SCHED;
            } else {
            PG8_LDB(B0, 0, 0); PG8_SCHED; PG8_LDA(At, 0, 0); PG8_STAGE(PG8_SA(1, 1), a1 + hstep, voffA);
            PG8_WAIT_L(8); PG8_BAR; PG8_WAIT_L(0); PG8_MMA(0, 0, At, B0); PG8_BAR; PG8_SCHED;
            PG8_LDB(B1, 0, 1); PG8_STAGE(PG8_SB(0, 0), b2, voffB);
            PG8_BAR; PG8_WAIT_L(0); PG8_MMA(0, 1, At, B1); PG8_BAR;
            PG8_LDA(At, 0, 1); PG8_STAGE(PG8_SA(0, 0), a2, voffA);
            PG8_BAR; PG8_WAIT_L(0); PG8_MMA(1, 0, At, B0); PG8_BAR; PG8_SCHED;
            PG8_STAGE(PG8_SB(0, 1), b2 + hstep, voffB);
            PG8_WAIT_V(6); PG8_BAR; PG8_MMA(1, 1, At, B1); PG8_BAR;
            PG8_LDB(B0, 1, 0); PG8_SCHED; PG8_LDA(At, 1, 0); PG8_STAGE(PG8_SA(0, 1), a2 + hstep, voffA);
            PG8_WAIT_L(8); PG8_BAR; PG8_WAIT_L(0); PG8_MMA(0, 0, At, B0); PG8_BAR; PG8_SCHED;
            PG8_LDB(B1, 1, 1); PG8_STAGE(PG8_SB(1, 0), b3, voffB);
            PG8_BAR; PG8_WAIT_L(0); PG8_MMA(0, 1, At, B1); PG8_BAR;
            PG8_LDA(At, 1, 1); PG8_STAGE(PG8_SA(1, 0), a3, voffA);
            PG8_BAR; PG8_WAIT_L(0); PG8_MMA(1, 0, At, B0); PG8_BAR; PG8_SCHED;
            PG8_STAGE(PG8_SB(1, 1), b3 + hstep, voffB);
            PG8_WAIT_V(6); PG8_BAR; PG8_MMA(1, 1, At, B1); PG8_BAR;
            }
        }
        if constexpr (ALIGN_EPI) { if (wr == 0) PG8_BAR; }
        if constexpr (!Epi::AFTER_DRAIN) { E(acc, cur, wr, wc, fr, fq); S.done(cur); }
        if (!has_next) break;
#pragma unroll
        for (int a = 0; a < 2; ++a)
#pragma unroll
            for (int b = 0; b < 2; ++b)
#pragma unroll
                for (int m = 0; m < 4; ++m)
#pragma unroll
                    for (int n = 0; n < 2; ++n) acc[a][b][m][n] = (f32x4){0.f, 0.f, 0.f, 0.f};
        cur = nxt; cA = nA; cB = nB; ++ui;
        if constexpr (ALIGN_EPI) { if (wr == 1) PG8_BAR; }
    }
    PG8_WAIT_V(0);
    if constexpr (!ALIGN_EPI) { if (wr == 0) PG8_BAR; }
    PG8_BAR;
    if constexpr (Epi::AFTER_DRAIN) { E.fused(acc, cur, wr, wc, fr, fq, lds, wid, lane); S.done(cur); }
#undef PG8_SA
#undef PG8_SB
#undef PG8_STAGE
#undef PG8_LDA
#undef PG8_LDB
#undef PG8_MMA
#undef PG8_WAIT_V
#undef PG8_WAIT_L
#undef PG8_BAR
#undef PG8_SCHED
}
}

constexpr int MTOK = 49152, DM = 1024, NBATCH = 17, NLAYER = 4, PIN = 2944, PLD = 3072, DFF = 2816, NMOD = 6144;
constexpr int NWAVES = 8, NTHR = 512;
constexpr float EPS_F = 1e-6f, GN_EPS_F = 64e-5f;
constexpr size_t MiB = 1u << 20;
constexpr size_t WS_MOD = 1 * MiB;
constexpr size_t WS_WIN = 3 * MiB;
constexpr size_t WS_WOUT = 9 * MiB;
constexpr size_t WS_WGU = 11 * MiB;
constexpr size_t WS_WDN = 22 * MiB;
constexpr size_t WS_WSP = 27 * MiB + 512 * 1024;
constexpr size_t WS_XN = 28 * MiB;
constexpr size_t WS_P = 124 * MiB;
constexpr size_t WS_SB = 508 * MiB;
constexpr size_t WS_LORA = 444 * MiB;
constexpr size_t WS_END = 510 * MiB;
constexpr int LDS_BYTES = 151552;

#define LAS __attribute__((address_space(3)))
typedef unsigned short bf16;
typedef unsigned v4u __attribute__((ext_vector_type(4)));
typedef unsigned v2u __attribute__((ext_vector_type(2)));
typedef float f32x4 __attribute__((ext_vector_type(4)));
typedef float f32x16 __attribute__((ext_vector_type(16)));
typedef short bf16x8 __attribute__((ext_vector_type(8)));
#define LDS_WAIT() asm volatile("s_waitcnt lgkmcnt(0)" ::: "memory")
typedef __bf16 bf16v2_t __attribute__((ext_vector_type(2)));
typedef float f32v2_t __attribute__((ext_vector_type(2)));
__device__ __forceinline__ unsigned pk2(float lo, float hi) { const f32v2_t v = {lo, hi}; const bf16v2_t b = __builtin_convertvector(v, bf16v2_t); return __builtin_bit_cast(unsigned, b); }
__device__ __forceinline__ unsigned f2bf(float f) { return pk2(f, f) & 0xffffu; }
__device__ __forceinline__ float bf2f(unsigned h) { return __builtin_bit_cast(float, h << 16); }
__device__ __forceinline__ float ldbf(const bf16* p) { return bf2f((unsigned)*p); }
template <int CTRL> __device__ __forceinline__ float dpp_f(float v) { return __builtin_bit_cast(float, __builtin_amdgcn_update_dpp(0, __builtin_bit_cast(int, v), CTRL, 0xF, 0xF, true)); }
typedef float f32x2 __attribute__((ext_vector_type(2)));
__device__ __forceinline__ float red16(float p) { p += dpp_f<0xB1>(p); p += dpp_f<0x4E>(p); p += dpp_f<0x141>(p); p += dpp_f<0x140>(p); return p; }
__device__ __forceinline__ float wave_sum(float v) {
    v = red16(v); const int x = __builtin_bit_cast(int, v);
    const float a = __builtin_bit_cast(float, __builtin_amdgcn_readlane(x, 0)), b = __builtin_bit_cast(float, __builtin_amdgcn_readlane(x, 16)), c = __builtin_bit_cast(float, __builtin_amdgcn_readlane(x, 32)), d = __builtin_bit_cast(float, __builtin_amdgcn_readlane(x, 48));
    return (a + b) + (c + d);
}
__device__ __forceinline__ float red8(float p) { p += dpp_f<0xB1>(p); p += dpp_f<0x4E>(p); p += dpp_f<0x141>(p); return p; }
__device__ __forceinline__ float gelu_f(float v) {
    const float t = __builtin_amdgcn_rcpf(fabsf(v) * 0.2316418882f + 1.0f);
    float q = t * 0.5307027145f + (-0.7265760135f); q = q * t + 0.7107068705f; q = q * t + (-0.142248368f); q = q * t + 0.127414796f; q = q * t;
    const float e = __builtin_amdgcn_exp2f((v * v) * (-0.72134752044f)); const float m = v * (q * e);
    return v < 0.f ? m : v - m;
}
__device__ __forceinline__ float sigmoid_f(float x) { return 1.f / (1.f + __expf(-x)); }

struct Args { const float* in[29]; float* out; unsigned char* ws; int ph_lo, ph_hi; };

__device__ __forceinline__ void transpose_item(const float* W, int K, int N, bf16* WT, int kb, int nb, int row_off, LAS float* scr, int lane) {
    const int k0 = 64 * kb, n0 = 32 * nb;
#pragma unroll 8
    for (int i = 0; i < 32; ++i) { const int kk = 2 * i + (lane >> 5); scr[kk * 33 + (lane & 31)] = W[(size_t)(k0 + kk) * N + n0 + (lane & 31)]; }
    LDS_WAIT(); asm volatile("" ::: "memory");
    const int c = lane & 7;
#pragma unroll
    for (int j = 0; j < 4; ++j) { const int n = (lane >> 3) + 8 * j; const LAS float* s = scr + (8 * c) * 33 + n;
        v4u o; o.x = pk2(s[0 * 33], s[1 * 33]); o.y = pk2(s[2 * 33], s[3 * 33]); o.z = pk2(s[4 * 33], s[5 * 33]); o.w = pk2(s[6 * 33], s[7 * 33]);
        *(v4u*)(WT + (size_t)(row_off + n0 + n) * K + k0 + 8 * c) = o; }
    LDS_WAIT(); asm volatile("" ::: "memory");
}
__device__ __forceinline__ void convert_weights(const Args& a, int l, LAS unsigned char* lds, int gw, int NGW, int wave, int lane) {
    LAS float* scr = (LAS float*)(lds + wave * 16384);
    const float* w_in = a.in[7] + (size_t)l * 1024 * PIN; const float* w_out = a.in[24] + (size_t)l * 1024 * 1024;
    const float* w_gu = a.in[26] + (size_t)l * 1024 * 5632; const float* w_dn = a.in[27] + (size_t)l * DFF * 1024;
    bf16* Win = (bf16*)(a.ws + WS_WIN); bf16* Wout = (bf16*)(a.ws + WS_WOUT); bf16* Wgu = (bf16*)(a.ws + WS_WGU); bf16* Wdn = (bf16*)(a.ws + WS_WDN);
    constexpr int I_IN = 16 * 92, I_OUT = 16 * 32, I_GU = 16 * 176, I_DN = 44 * 32, I_PAD = 128;
    constexpr int NIT = I_IN + I_OUT + I_GU + I_DN + I_PAD;
    {
        bf16* LW = (bf16*)(a.ws + WS_LORA); bf16* LA = LW + 65536; bf16* LG = LA + 65536;
        const float* w2 = a.in[15] + (size_t)l * 65536; const float* a2 = a.in[17] + (size_t)l * 65536; const float* g2 = a.in[18] + (size_t)l * 65536;
        for (int e = gw * 64 + lane; e < 65536; e += NGW * 64) { const int col = e & 511, i = (e >> 9) & 63, dir = e >> 15;
            const int dst = ((dir * 8 + (col >> 6)) * 64 + (col & 63)) * 64 + i; LW[dst] = (bf16)f2bf(w2[e]); LA[dst] = (bf16)f2bf(a2[e]); }
        for (int e = gw * 64 + lane; e < 65536; e += NGW * 64) { const int col = e & 511, i = e >> 9;
            LG[((col >> 6) * 64 + (col & 63)) * 128 + i] = (bf16)f2bf(g2[e]); }
    }
    for (int it = gw; it < NIT; it += NGW) {
        int r = it;
        if (r < I_IN) { transpose_item(w_in, 1024, PIN, Win, r / 92, r % 92, 0, scr, lane); continue; } r -= I_IN;
        if (r < I_OUT) { transpose_item(w_out, 1024, 1024, Wout, r / 32, r % 32, 0, scr, lane); continue; } r -= I_OUT;
        if (r < I_GU) { const int kb = r / 176, nb = r % 176; const int n0 = 32 * nb; const int up = n0 >= DFF ? 1 : 0; const int j0 = n0 - up * DFF;
            const int dest = 256 * (j0 >> 7) + 128 * up + (j0 & 127);
            transpose_item(w_gu, 1024, 5632, Wgu, kb, nb, dest - n0, scr, lane); continue; } r -= I_GU;
        if (r < I_DN) { transpose_item(w_dn, DFF, 1024, Wdn, r / 32, r % 32, 0, scr, lane); continue; } r -= I_DN;
        { v4u z = {0u, 0u, 0u, 0u}; v4u* p = (v4u*)(Win + (size_t)(PIN + r) * 1024);
          p[lane] = z; p[lane + 64] = z; }
    }
}

__device__ __forceinline__ void mod_phase(const Args& a, LAS unsigned char* lds, int tid) {
    LAS float* sc = (LAS float*)lds;
    LAS float* part = (LAS float*)(lds + 81920);
    const float* cp = a.in[2]; const float* cs = a.in[3];
    for (int e = tid; e < 20 * 1024; e += NTHR) { const int b = e >> 10, k = e & 1023; float v = 0.f;
        if (b < 17) { const float cv = b < 16 ? cp[b * 1024 + k] : cs[k]; v = cv / (1.f + __expf(-cv)); }
        sc[k * 20 + b] = v; }
    __syncthreads();
    float* mod = (float*)(a.ws + WS_MOD);
    const int col = tid & 63, kg = tid >> 6;
    for (int item = blockIdx.x; item < 4 * 96; item += gridDim.x) {
        const int l = item / 96, n0 = (item % 96) * 64;
        float acc[17];
#pragma unroll
        for (int b = 0; b < 17; ++b) acc[b] = 0.f;
        const float* wp = a.in[4] + ((size_t)l * 1024 + kg * 128) * NMOD + n0 + col;
#pragma unroll 16
        for (int kk = 0; kk < 128; ++kk) { const float w = wp[(size_t)kk * NMOD]; const LAS float* s = sc + (kg * 128 + kk) * 20;
            const f32x4 s0 = *(const LAS f32x4*)(s), s1 = *(const LAS f32x4*)(s + 4), s2 = *(const LAS f32x4*)(s + 8), s3 = *(const LAS f32x4*)(s + 12); const float s4 = s[16];
#pragma unroll
            for (int j = 0; j < 4; ++j) { acc[j] += s0[j] * w; acc[4 + j] += s1[j] * w; acc[8 + j] += s2[j] * w; acc[12 + j] += s3[j] * w; }
            acc[16] += s4 * w; }
#pragma unroll
        for (int b = 0; b < 17; ++b) part[(kg * 17 + b) * 64 + col] = acc[b];
        __syncthreads();
        for (int e = tid; e < 17 * 64; e += NTHR) { const int b = e >> 6, cc = e & 63; float s = 0.f;
#pragma unroll
            for (int g = 0; g < 8; ++g) s += part[(g * 17 + b) * 64 + cc];
            mod[((size_t)l * 17 + b) * NMOD + n0 + cc] = s + a.in[5][l * NMOD + n0 + cc]; }
        __syncthreads();
    }
    { bf16* wsp = (bf16*)(a.ws + WS_WSP); const float* src = a.in[10];
      for (int e = blockIdx.x * NTHR + tid; e < 262144 / 2; e += gridDim.x * NTHR) ((unsigned*)wsp)[e] = pk2(src[2 * e], src[2 * e + 1]); }
}

constexpr int NR = 4;
__device__ __forceinline__ void norm_phase(const float* xa, const float* xb, const float* g, const float* modl, int sh_off, int sc_off, bf16* XN, int gw, int NGW, int lane) {
    for (int row0 = gw; row0 < MTOK; row0 += NR * NGW) {
        f32x4 v[NR][4]; float s[NR];
#pragma unroll
        for (int q = 0; q < NR; ++q) { const int row = row0 + q * NGW; s[q] = 0.f; if (row < MTOK) { const float* xr = row < 32768 ? xa + (size_t)row * 1024 : xb + (size_t)(row - 32768) * 1024;
#pragma unroll
            for (int j = 0; j < 4; ++j) v[q][j] = ((const f32x4*)xr)[lane + 64 * j]; } }
#pragma unroll
        for (int q = 0; q < NR; ++q) if (row0 + q * NGW < MTOK) {
#pragma unroll
            for (int j = 0; j < 4; ++j) s[q] += (v[q][j].x * v[q][j].x + v[q][j].y * v[q][j].y) + (v[q][j].z * v[q][j].z + v[q][j].w * v[q][j].w); }
#pragma unroll
        for (int q = 0; q < NR; ++q) if (row0 + q * NGW < MTOK) { const int row = row0 + q * NGW; const int b = pg8::batch_of_row(row);
            const float rstd = rsqrtf(wave_sum(s[q]) * (1.f / 1024.f) + EPS_F);
            const float* mb = modl + (size_t)b * NMOD;
#pragma unroll
            for (int j = 0; j < 4; ++j) { const int col = 4 * lane + 256 * j;
                const f32x4 gv = *(const f32x4*)(g + col), scv = *(const f32x4*)(mb + sc_off + col), shv = *(const f32x4*)(mb + sh_off + col);
                const f32x4 o = v[q][j] * rstd * gv * (scv + 1.f) + shv;
                v2u w; w.x = pk2(o.x, o.y); w.y = pk2(o.z, o.w); *(v2u*)(XN + (size_t)row * 1024 + col) = w; } }
    }
}
__device__ __forceinline__ void final_norm_phase(float* x, const float* g, int gw, int NGW, int lane) {
    for (int row0 = gw; row0 < MTOK; row0 += NR * NGW) {
        f32x4 v[NR][4]; float s[NR];
#pragma unroll
        for (int q = 0; q < NR; ++q) { s[q] = 0.f; if (row0 + q * NGW < MTOK) { const float* xr = x + (size_t)(row0 + q * NGW) * 1024;
#pragma unroll
            for (int j = 0; j < 4; ++j) v[q][j] = ((const f32x4*)xr)[lane + 64 * j]; } }
#pragma unroll
        for (int q = 0; q < NR; ++q) if (row0 + q * NGW < MTOK) {
#pragma unroll
            for (int j = 0; j < 4; ++j) s[q] += (v[q][j].x * v[q][j].x + v[q][j].y * v[q][j].y) + (v[q][j].z * v[q][j].z + v[q][j].w * v[q][j].w); }
#pragma unroll
        for (int q = 0; q < NR; ++q) if (row0 + q * NGW < MTOK) { float* xr = x + (size_t)(row0 + q * NGW) * 1024; const float rstd = rsqrtf(wave_sum(s[q]) * (1.f / 1024.f) + EPS_F);
#pragma unroll
            for (int j = 0; j < 4; ++j) { const f32x4 gv = *(const f32x4*)(g + 4 * lane + 256 * j); ((f32x4*)xr)[lane + 64 * j] = v[q][j] * rstd * gv; } }
    }
}

__device__ __forceinline__ void mixer_a_item(LAS unsigned char* lds, const Args& a, int l, int item, int tid, int wave, int lane) {
    const bf16* P = (const bf16*)(a.ws + WS_P); bf16* Y = (bf16*)(a.ws + WS_XN); const bf16* wsp = (const bf16*)(a.ws + WS_WSP) + (size_t)l * 65536;
    const float* ln_w = a.in[8] + l * 512; const float* ln_b = a.in[9] + l * 512; const float* b_sp = a.in[11] + l * 512; const float* out_g = a.in[12] + l * 512;
    const int c = item >> 2, h = item & 3, r0 = c * 128;
    LAS bf16* vnT = (LAS bf16*)lds;
    LAS float* ob = (LAS float*)(lds + 34816);
    {
        const float lw0 = ln_w[h * 128 + 2 * lane], lw1 = ln_w[h * 128 + 2 * lane + 1], lb0 = ln_b[h * 128 + 2 * lane], lb1 = ln_b[h * 128 + 2 * lane + 1];
        unsigned wv[16];
#pragma unroll
        for (int qi = 0; qi < 16; ++qi) wv[qi] = *(const unsigned*)(P + (size_t)(r0 + 16 * wave + qi) * PLD + 512 + h * 128 + 2 * lane);
#pragma unroll
        for (int qi = 0; qi < 16; ++qi) { const int q = 16 * wave + qi; const unsigned w = wv[qi];
            const float v0 = gelu_f(bf2f(w & 0xffffu)), v1 = gelu_f(bf2f(w >> 16));
            const float mu = wave_sum(v0 + v1) * (1.f / 128.f); const float d0 = v0 - mu, d1 = v1 - mu;
            const float rstd = rsqrtf(wave_sum(d0 * d0 + d1 * d1) * (1.f / 128.f) + EPS_F);
            vnT[(2 * lane) * 136 + q] = (bf16)f2bf(d0 * rstd * lw0 + lb0); vnT[(2 * lane + 1) * 136 + q] = (bf16)f2bf(d1 * rstd * lw1 + lb1); }
    }
    __syncthreads();
    const int wp = wave >> 1, wd = wave & 1, l31 = lane & 31, hi = lane >> 5;
    f32x16 acc[2];
#pragma unroll
    for (int t = 0; t < 2; ++t)
#pragma unroll
        for (int r = 0; r < 16; ++r) acc[t][r] = 0.f;
#pragma unroll
    for (int ks = 0; ks < 8; ++ks) { const int k0 = 16 * ks;
        const bf16x8 af = *(const bf16x8*)(wsp + (size_t)h * 16384 + (32 * wp + l31) * 128 + k0 + 8 * hi);
#pragma unroll
        for (int t = 0; t < 2; ++t) { const bf16x8 bfr = *(const LAS bf16x8*)(vnT + (64 * wd + 32 * t + l31) * 136 + k0 + 8 * hi);
            acc[t] = __builtin_amdgcn_mfma_f32_32x32x16_bf16(af, bfr, acc[t], 0, 0, 0); } }
#pragma unroll
    for (int t = 0; t < 2; ++t) { const int d = 64 * wd + 32 * t + l31; float uu[16];
#pragma unroll
        for (int r = 0; r < 16; ++r) uu[r] = ldbf(P + (size_t)(r0 + 32 * wp + (r & 3) + 8 * (r >> 2) + 4 * hi) * PLD + h * 128 + d);
#pragma unroll
        for (int r = 0; r < 16; ++r) { const int p = 32 * wp + (r & 3) + 8 * (r >> 2) + 4 * hi;
            ob[p * 132 + d] = gelu_f(uu[r]) * (acc[t][r] + b_sp[h * 128 + p]); } }
    __syncthreads();
    {
        const float g0 = out_g[h * 128 + 2 * lane], g1 = out_g[h * 128 + 2 * lane + 1];
        for (int pi = 0; pi < 16; ++pi) { const int p = 16 * wave + pi; const float o0 = ob[p * 132 + 2 * lane], o1 = ob[p * 132 + 2 * lane + 1];
            const float rstd = rsqrtf(wave_sum(o0 * o0 + o1 * o1) * (1.f / 128.f) + EPS_F);
            *(unsigned*)(Y + (size_t)(r0 + p) * 1024 + h * 128 + 2 * lane) = pk2(o0 * rstd * g0, o1 * rstd * g1); }
    }
    __syncthreads();
}

__device__ __forceinline__ float ts_val(const bf16* P, size_t row, int pos, int len, int j, const float* mu) {
    const bf16* p = P + row * PLD + 1024 + j; const float pc = ldbf(p); const float pp = pos > 0 ? ldbf(p - PLD) : 0.f; const float pn = pos < len - 1 ? ldbf(p + PLD) : 0.f;
    return pc + mu[j] * (pp - pc) + mu[1920 + j] * (pn - pc);
}
constexpr size_t WS_AB = 412 * MiB;
struct ScanLds { LAS bf16 *W2t, *A2t, *G2t, *DWb, *DAb, *DGb, *Kap, *Rt, *Kt, *Bt, *Kh, *Bh, *Vt, *GVb, *Akk, *Akr, *Abr, *S16, *Ub, *U0b, *BQ, *BQT, *BW, *TiT; LAS float *Rs, *KRs, *Vs, *LWs, *LAs, *Ys, *WT, *Wend, *SBs, *MU; };
template <int NV> __device__ __forceinline__ ScanLds scan_lds(LAS unsigned char* lds) {
    ScanLds L; L.W2t = (LAS bf16*)(lds); L.A2t = (LAS bf16*)(lds + 9216); L.G2t = (LAS bf16*)(lds + 18432);
    L.Rs = (LAS float*)(lds + 36864); L.KRs = (LAS float*)(lds + 45056); L.U0b = (LAS bf16*)(lds + 36864); L.Ys = (LAS float*)(lds + 45056);
    L.Vs = (LAS float*)(lds + 53248);
    L.LWs = (LAS float*)(lds + 61440); L.LAs = (LAS float*)(lds + 69632); L.DWb = (LAS bf16*)(lds + 77824); L.DAb = (LAS bf16*)(lds + 82432); L.DGb = (LAS bf16*)(lds + 87040);
    L.S16 = (LAS bf16*)(lds + 61440); L.Ub = (LAS bf16*)(lds + 61440 + NV * 144);
    L.BQ = (LAS bf16*)(lds + 61440 + NV * 224); L.BQT = (LAS bf16*)(lds + 61440 + NV * 224 + 2560);
    if (NV == 64) { L.BW = (LAS bf16*)(lds + 61440 + NV * 224 + 5120); L.TiT = (LAS bf16*)(lds + 61440 + NV * 224 + 7680); }
    else { L.BW = (LAS bf16*)(lds + 36864 + 10240); L.TiT = (LAS bf16*)(lds + 36864 + 12800); }
    L.Kap = (LAS bf16*)(lds + 95744); L.Rt = (LAS bf16*)(lds + 100352); L.Kt = (LAS bf16*)(lds + 104960); L.Bt = (LAS bf16*)(lds + 109568);
    L.Kh = (LAS bf16*)(lds + 114176); L.Bh = (LAS bf16*)(lds + 119296); L.Vt = (LAS bf16*)(lds + 124416); L.GVb = (LAS bf16*)(lds + 124416 + 5120);
    L.WT = (LAS float*)(lds + 134656); L.Wend = (LAS float*)(lds + 136704); L.SBs = (LAS float*)(lds + 136960);
    L.MU = (LAS float*)(lds + 147456);
    L.Akk = (LAS bf16*)(lds + 137088); L.Akr = (LAS bf16*)(lds + 139648); L.Abr = (LAS bf16*)(lds + 142208); return L;
}
__device__ __forceinline__ float fast_sigmoid(float x) { return __builtin_amdgcn_rcpf(1.f + __expf(-x)); }
__device__ __forceinline__ float fast_tanh(float x) { return 1.f - 2.f * __builtin_amdgcn_rcpf(1.f + __expf(2.f * x)); }
struct ScanCh { float kkw, kaw, rkw, w0v, a0v; };
__device__ __forceinline__ f32x4 ts4(const bf16* P, size_t row, int pos, int len, int j, const float* mu) {
    const bf16* p = P + row * PLD + 1024 + j;
    const v2u c = *(const v2u*)p; v2u pv = {0u, 0u}, nv = {0u, 0u};
    if (pos > 0) pv = *(const v2u*)(p - PLD);
    if (pos < len - 1) nv = *(const v2u*)(p + PLD);
    const f32x4 pc = {bf2f(c.x & 0xffffu), bf2f(c.x >> 16), bf2f(c.y & 0xffffu), bf2f(c.y >> 16)};
    const f32x4 pp = {bf2f(pv.x & 0xffffu), bf2f(pv.x >> 16), bf2f(pv.y & 0xffffu), bf2f(pv.y >> 16)};
    const f32x4 pn = {bf2f(nv.x & 0xffffu), bf2f(nv.x >> 16), bf2f(nv.y & 0xffffu), bf2f(nv.y >> 16)};
    const f32x4 m0 = *(const f32x4*)(mu + j), m1 = *(const f32x4*)(mu + 1920 + j);
    return pc + m0 * (pp - pc) + m1 * (pn - pc);
}
struct RawQ { v2u c, p, n; };
__device__ __forceinline__ RawQ ts4_load(const bf16* P, size_t row, int pos, int len, int j) {
    const bf16* p = P + row * PLD + 1024 + j; RawQ q; q.c = *(const v2u*)p; q.p = (v2u){0u, 0u}; q.n = (v2u){0u, 0u};
    if (pos > 0) q.p = *(const v2u*)(p - PLD);
    if (pos < len - 1) q.n = *(const v2u*)(p + PLD);
    return q;
}
__device__ __forceinline__ f32x4 ts4_apply(const RawQ& q, const LAS float* MU, int grp, int col) {
    const f32x4 pc = {bf2f(q.c.x & 0xffffu), bf2f(q.c.x >> 16), bf2f(q.c.y & 0xffffu), bf2f(q.c.y >> 16)};
    const f32x4 pp = {bf2f(q.p.x & 0xffffu), bf2f(q.p.x >> 16), bf2f(q.p.y & 0xffffu), bf2f(q.p.y >> 16)};
    const f32x4 pn = {bf2f(q.n.x & 0xffffu), bf2f(q.n.x >> 16), bf2f(q.n.y & 0xffffu), bf2f(q.n.y >> 16)};
    const f32x4 m0 = *(const LAS f32x4*)(MU + (grp * 2) * 64 + col), m1 = *(const LAS f32x4*)(MU + (grp * 2 + 1) * 64 + col);
    return pc + m0 * (pp - pc) + m1 * (pn - pc);
}
struct Raw { RawQ q[5]; RawQ g[2]; };
template <bool FULL> __device__ __forceinline__ void raw_load(Raw& R, const bf16* P, int s0, int len, int pos0, int h, int dir, bool doG, int tid) {
    const int t = tid >> 4, cq = (tid & 15) * 4; const int pos = pos0 + (dir ? 31 - t : t); const size_t row = (size_t)(s0 + pos);
    if (FULL) R.q[0] = ts4_load(P, row, pos, len, h * 64 + cq);
    R.q[1] = ts4_load(P, row, pos, len, 512 + h * 64 + cq); R.q[2] = ts4_load(P, row, pos, len, 1024 + h * 64 + cq);
    R.q[3] = ts4_load(P, row, pos, len, 1536 + dir * 64 + cq); R.q[4] = ts4_load(P, row, pos, len, 1664 + dir * 64 + cq);
    if (doG) { const int c8 = (tid & 15) * 8; R.g[0] = ts4_load(P, row, pos, len, 1792 + c8); R.g[1] = ts4_load(P, row, pos, len, 1792 + c8 + 4); }
}
__device__ __forceinline__ int mrow(int r, int hi) { return (r & 3) + 8 * (r >> 2) + 4 * hi; }
template <int KS> __device__ __forceinline__ void mm32(f32x16& acc, const LAS bf16* X, int px, int xrow0, const LAS bf16* Y, int py, int yrow0, int l31, int hi) {
#pragma unroll
    for (int ks = 0; ks < KS; ++ks) { const bf16x8 af = *(const LAS bf16x8*)(X + (xrow0 + l31) * px + 16 * ks + 8 * hi); const bf16x8 bfr = *(const LAS bf16x8*)(Y + (yrow0 + l31) * py + 16 * ks + 8 * hi);
        acc = __builtin_amdgcn_mfma_f32_32x32x16_bf16(af, bfr, acc, 0, 0, 0); }
}
template <int NV, bool FULL> __device__ __forceinline__ void scan_prep(const ScanLds& L, Raw& R, const bf16* P, const float* mu, int s0, int len, int pos0_next, bool has_next, int h, int dir, const ScanCh& ch, bool doG, int tid_, int wave, int lane_) {
    int tid = tid_, lane = lane_; asm volatile("" : "+v"(tid), "+v"(lane));
    __syncthreads();
    {
        const int t = tid >> 4, cq = (tid & 15) * 4;
        const LAS float* MU = L.MU;
        if (FULL) *(LAS f32x4*)(L.Rs + t * 64 + cq) = ts4_apply(R.q[0], MU, 0, cq);
        *(LAS f32x4*)(L.KRs + t * 64 + cq) = ts4_apply(R.q[1], MU, 1, cq);
        *(LAS f32x4*)(L.Vs + t * 64 + cq) = ts4_apply(R.q[2], MU, 2, cq);
        const f32x4 dw = ts4_apply(R.q[3], MU, 3, cq), da = ts4_apply(R.q[4], MU, 4, cq);
        v2u w; w.x = pk2(fast_tanh(dw.x), fast_tanh(dw.y)); w.y = pk2(fast_tanh(dw.z), fast_tanh(dw.w)); *(LAS v2u*)(L.DWb + t * 72 + cq) = w;
        v2u x; x.x = pk2(da.x, da.y); x.y = pk2(da.z, da.w); *(LAS v2u*)(L.DAb + t * 72 + cq) = x;
        if (doG) { const int c8 = (tid & 15) * 8; const f32x4 g0 = ts4_apply(R.g[0], MU, 5 + (c8 >> 6), c8 & 63), g1 = ts4_apply(R.g[1], MU, 5 + (c8 >> 6), (c8 & 63) + 4);
            v4u gq; gq.x = pk2(fast_sigmoid(g0.x), fast_sigmoid(g0.y)); gq.y = pk2(fast_sigmoid(g0.z), fast_sigmoid(g0.w)); gq.z = pk2(fast_sigmoid(g1.x), fast_sigmoid(g1.y)); gq.w = pk2(fast_sigmoid(g1.z), fast_sigmoid(g1.w));
            *(LAS v4u*)(L.DGb + t * 136 + c8) = gq; }
        if (has_next) raw_load<FULL>(R, P, s0, len, pos0_next, h, dir, doG, tid);
    }
    __syncthreads();
    const int l15 = lane & 15, lq = lane >> 4, th = wave >> 2, cqw = wave & 3, c = 16 * cqw + l15, tg = 4 * th + lq, t0 = 4 * tg;
    LAS float* PK = L.LWs; LAS float* PSB = L.LWs + 128;
    f32x4 alw = {0.f, 0.f, 0.f, 0.f}, ala = {0.f, 0.f, 0.f, 0.f};
#pragma unroll
    for (int ks = 0; ks < 2; ++ks) {
        const bf16x8 aw = *(const LAS bf16x8*)(L.DWb + (16 * th + l15) * 72 + 32 * ks + 8 * lq), bw = *(const LAS bf16x8*)(L.W2t + c * 72 + 32 * ks + 8 * lq);
        const bf16x8 aa = *(const LAS bf16x8*)(L.DAb + (16 * th + l15) * 72 + 32 * ks + 8 * lq), ba = *(const LAS bf16x8*)(L.A2t + c * 72 + 32 * ks + 8 * lq);
        alw = __builtin_amdgcn_mfma_f32_16x16x32_bf16(aw, bw, alw, 0, 0, 0); ala = __builtin_amdgcn_mfma_f32_16x16x32_bf16(aa, ba, ala, 0, 0, 0); }
    if (doG) { f32x4 ag = {0.f, 0.f, 0.f, 0.f};
#pragma unroll
        for (int ks = 0; ks < 4; ++ks) { const bf16x8 ga = *(const LAS bf16x8*)(L.DGb + (16 * th + l15) * 136 + 32 * ks + 8 * lq), gb = *(const LAS bf16x8*)(L.G2t + c * 136 + 32 * ks + 8 * lq);
            ag = __builtin_amdgcn_mfma_f32_16x16x32_bf16(ga, gb, ag, 0, 0, 0); }
#pragma unroll
        for (int r = 0; r < 4; ++r) L.GVb[(t0 + r) * 64 + c] = (bf16)f2bf(ag[r]); }
    float ld[4], kkr[4], av4[4], kd[4], rr[4], vv[4];
#pragma unroll
    for (int r = 0; r < 4; ++r) { const int t = t0 + r;
        ld[r] = -0.60653065971f * fast_sigmoid(alw[r] + ch.w0v);
        av4[r] = fast_sigmoid(ala[r] + ch.a0v);
        const float kraw = L.KRs[t * 64 + c]; kkr[r] = kraw * ch.kkw; kd[r] = kraw * (1.f + (av4[r] - 1.f) * ch.kaw);
        rr[r] = FULL ? L.Rs[t * 64 + c] : 0.f; vv[r] = L.Vs[t * 64 + c];
        const float pk = red16(kkr[r] * kkr[r]); if (l15 == 0) PK[t * 4 + cqw] = pk;
        if (FULL) { const float ps = red16(rr[r] * kd[r] * ch.rkw); if (l15 == 0) PSB[t * 4 + cqw] = ps; } }
    float pl[4]; pl[0] = ld[0]; pl[1] = pl[0] + ld[1]; pl[2] = pl[1] + ld[2]; pl[3] = pl[2] + ld[3];
    L.WT[tg * 64 + c] = pl[3];
    __syncthreads();
    float off = 0.f, tot = 0.f;
#pragma unroll
    for (int w = 0; w < 8; ++w) { const float x = L.WT[w * 64 + c]; tot += x; if (w < tg) off += x; }
    const float etot = __expf(tot);
    if (tg == 0) L.Wend[c] = etot;
    float khv[4], bhv[4]; float e_last = __expf(off);
#pragma unroll
    for (int r = 0; r < 4; ++r) { const int t = t0 + r; const float Lc = off + pl[r];
        const f32x4 p4 = *(const LAS f32x4*)(PK + t * 4); const float kk = kkr[r] * rsqrtf(fmaxf((p4.x + p4.y) + (p4.z + p4.w), 1e-24f)); const float bd = kk * av4[r];
        if (FULL && cqw == 0 && l15 == 0) { const f32x4 s4 = *(const LAS f32x4*)(PSB + t * 4); L.SBs[t] = (s4.x + s4.y) + (s4.z + s4.w); }
        const float e_in = __expf(Lc), e_prev = e_last, e_inv = __builtin_amdgcn_rcpf(e_in), e_end = etot * e_inv; e_last = e_in;
        L.Kap[t * 72 + c] = (bf16)f2bf(kk * e_prev); if (FULL) L.Rt[t * 72 + c] = (bf16)f2bf(rr[r] * e_in);
        L.Kt[t * 72 + c] = (bf16)f2bf(kd[r] * e_inv); L.Bt[t * 72 + c] = (bf16)f2bf(bd * e_inv);
        khv[r] = kd[r] * e_end; bhv[r] = -bd * e_end; }
    { v2u w; w.x = pk2(khv[0], khv[1]); w.y = pk2(khv[2], khv[3]); *(LAS v2u*)(L.Kh + c * 40 + t0) = w;
      v2u x; x.x = pk2(bhv[0], bhv[1]); x.y = pk2(bhv[2], bhv[3]); *(LAS v2u*)(L.Bh + c * 40 + t0) = x;
      v2u y; y.x = pk2(vv[0], vv[1]); y.y = pk2(vv[2], vv[3]); *(LAS v2u*)(L.Vt + c * 40 + t0) = y; }
    __syncthreads();
}
__device__ __forceinline__ void nat_store(LAS bf16* buf, const f32x16& d, int l31, int hi) {
#pragma unroll
    for (int g = 0; g < 4; ++g) { v2u w; w.x = pk2(d[4 * g], d[4 * g + 1]); w.y = pk2(d[4 * g + 2], d[4 * g + 3]); *(LAS v2u*)(buf + l31 * 40 + 8 * g + 4 * hi) = w; }
}
template <int NV, bool WITHY> __device__ __forceinline__ void scan_chunk(const ScanLds& L, f32x16& st, bool hasT, int kt, int vt, int wave, int lane_, bf16* ypark = nullptr) {
    int lane = lane_; asm volatile("" : "+v"(lane));
    const int l31 = lane & 31, hi = lane >> 5;
    const int utile = (wave >= 1 && wave <= NV / 32) ? wave - 1 : -1;
    f32x16 Q, QT, W;
    if (hasT) {
#pragma unroll
        for (int g = 0; g < 4; ++g) { v2u w; w.x = pk2(st[4 * g], st[4 * g + 1]); w.y = pk2(st[4 * g + 2], st[4 * g + 3]); *(LAS v2u*)(L.S16 + (32 * vt + l31) * 72 + 32 * kt + 8 * g + 4 * hi) = w; }
    }
    if (wave == 0) {
#pragma unroll
        for (int r = 0; r < 16; ++r) { Q[r] = 0.f; QT[r] = 0.f; }
        mm32<4>(Q, L.Bt, 72, 0, L.Kap, 72, 0, l31, hi);
        mm32<4>(QT, L.Kap, 72, 0, L.Bt, 72, 0, l31, hi);
#pragma unroll
        for (int r = 0; r < 16; ++r) { const int row = mrow(r, hi); Q[r] = row < l31 ? Q[r] : 0.f; QT[r] = l31 < row ? QT[r] : 0.f; W[r] = (row == l31 ? 1.f : 0.f) - QT[r]; }
        nat_store(L.BQ, Q, l31, hi); nat_store(L.BQT, QT, l31, hi);
        {   f32x16 Qn, QTn;
#pragma unroll
            for (int r = 0; r < 16; ++r) { Qn[r] = 0.f; QTn[r] = 0.f; }
            mm32<2>(Qn, L.BQT, 40, 0, L.BQ, 40, 0, l31, hi); mm32<2>(QTn, L.BQ, 40, 0, L.BQT, 40, 0, l31, hi); Q = Qn; QT = QTn; }
#pragma unroll
        for (int n = 1; n < 3; ++n) {
            nat_store(L.BQ, Q, l31, hi); nat_store(L.BQT, QT, l31, hi); nat_store(L.BW, W, l31, hi);
            f32x16 Qn, QTn;
#pragma unroll
            for (int r = 0; r < 16; ++r) { Qn[r] = 0.f; QTn[r] = 0.f; }
            mm32<2>(W, L.BQ, 40, 0, L.BW, 40, 0, l31, hi); mm32<2>(Qn, L.BQT, 40, 0, L.BQ, 40, 0, l31, hi); mm32<2>(QTn, L.BQ, 40, 0, L.BQT, 40, 0, l31, hi); Q = Qn; QT = QTn; }
    } else if (wave == 1) {
        f32x16 acc;
#pragma unroll
        for (int r = 0; r < 16; ++r) acc[r] = 0.f;
        mm32<4>(acc, L.Kt, 72, 0, L.Kap, 72, 0, l31, hi);
#pragma unroll
        for (int r = 0; r < 16; ++r) acc[r] = mrow(r, hi) < l31 ? acc[r] : 0.f;
        nat_store(L.Akk, acc, l31, hi);
    } else if (WITHY && (wave == 2 || wave == 3)) {
        f32x16 acc;
#pragma unroll
        for (int r = 0; r < 16; ++r) acc[r] = 0.f;
        mm32<4>(acc, wave == 2 ? L.Kt : L.Bt, 72, 0, L.Rt, 72, 0, l31, hi);
        const float sg = wave == 3 ? -1.f : 1.f;
#pragma unroll
        for (int r = 0; r < 16; ++r) acc[r] = mrow(r, hi) <= l31 ? sg * acc[r] : 0.f;
        nat_store(wave == 2 ? L.Akr : L.Abr, acc, l31, hi);
    }
    __syncthreads();
    f32x16 accy;
#pragma unroll
    for (int r = 0; r < 16; ++r) accy[r] = 0.f;
    if (utile >= 0) {
        f32x16 acc;
#pragma unroll
        for (int r = 0; r < 16; ++r) acc[r] = 0.f;
        mm32<4>(acc, L.Kap, 72, 0, L.S16, 72, 32 * utile, l31, hi);
        if (utile < 2) mm32<2>(acc, L.Akk, 40, 0, L.Vt, 40, 32 * utile, l31, hi);
        nat_store(L.U0b + 32 * utile * 40, acc, l31, hi);
        if (WITHY) { mm32<4>(accy, L.Rt, 72, 0, L.S16, 72, 32 * utile, l31, hi); mm32<2>(accy, L.Akr, 40, 0, L.Vt, 40, 32 * utile, l31, hi); }
    }
    if (wave == 0) {
#pragma unroll
        for (int n = 3; n < 5; ++n) {
            nat_store(L.BQ, Q, l31, hi); if (n < 4) nat_store(L.BQT, QT, l31, hi); nat_store(L.BW, W, l31, hi);
            f32x16 Qn, QTn;
#pragma unroll
            for (int r = 0; r < 16; ++r) { Qn[r] = 0.f; QTn[r] = 0.f; }
            mm32<2>(W, L.BQ, 40, 0, L.BW, 40, 0, l31, hi);
            if (n < 4) { mm32<2>(Qn, L.BQT, 40, 0, L.BQ, 40, 0, l31, hi); mm32<2>(QTn, L.BQ, 40, 0, L.BQT, 40, 0, l31, hi); Q = Qn; QT = QTn; } }
#pragma unroll
        for (int r = 0; r < 16; ++r) L.TiT[mrow(r, hi) * 40 + l31] = (bf16)f2bf(W[r]);
    }
    if (hasT) {
#pragma unroll
        for (int r = 0; r < 16; ++r) st[r] *= L.Wend[32 * kt + mrow(r, hi)];
        if (vt < 2) mm32<2>(st, L.Kh, 40, 32 * kt, L.Vt, 40, 32 * vt, l31, hi);
    }
    __syncthreads();
    if (utile >= 0) {
        f32x16 acc;
#pragma unroll
        for (int r = 0; r < 16; ++r) acc[r] = 0.f;
        mm32<2>(acc, L.TiT, 40, 0, L.U0b, 40, 32 * utile, l31, hi);
        nat_store(L.Ub + 32 * utile * 40, acc, l31, hi);
    }
    __syncthreads();
    if (WITHY && utile >= 0) {
        mm32<2>(accy, L.Abr, 40, 0, L.Ub, 40, 32 * utile, l31, hi);
        if (ypark) {
#pragma unroll
            for (int r = 0; r < 16; ++r) ypark[(size_t)mrow(r, hi) * 1024 + 32 * utile + l31] = (bf16)f2bf(accy[r]);
        } else {
#pragma unroll
            for (int r = 0; r < 16; ++r) L.Ys[mrow(r, hi) * 64 + 32 * utile + l31] = accy[r];
        }
    }
    if (hasT) mm32<2>(st, L.Bh, 40, 32 * kt, L.Ub, 40, 32 * vt, l31, hi);
}
__device__ __forceinline__ void scan_load_lora(const ScanLds& L, const Args& a, int l, int dir, int h, int tid) {
    __syncthreads();
    const bf16* LW = (const bf16*)(a.ws + WS_LORA) + (size_t)(dir * 8 + h) * 4096; const bf16* LA = LW + 65536;
    const int c = tid >> 3, part = (tid & 7) * 8;
    *(LAS v4u*)(L.W2t + c * 72 + part) = *(const v4u*)(LW + c * 64 + part); *(LAS v4u*)(L.A2t + c * 72 + part) = *(const v4u*)(LA + c * 64 + part);
    const float* mu = a.in[13] + (size_t)l * 2 * 1920;
    for (int e = tid; e < 896; e += NTHR) { const int grp = e >> 7, which = (e >> 6) & 1, col = e & 63;
        const int jb = grp == 0 ? h * 64 : grp == 1 ? 512 + h * 64 : grp == 2 ? 1024 + h * 64 : grp == 3 ? 1536 + dir * 64 : grp == 4 ? 1664 + dir * 64 : 1792 + (grp - 5) * 64;
        L.MU[e] = mu[which * 1920 + jb + col]; }
}
__device__ __forceinline__ void scan_load_g2(const ScanLds& L, const Args& a, int h, int tid) {
    const bf16* LG = (const bf16*)(a.ws + WS_LORA) + 131072 + (size_t)h * 8192;
#pragma unroll
    for (int q = 0; q < 2; ++q) { const int e = tid + q * NTHR; const int c = e >> 4, part = (e & 15) * 8; *(LAS v4u*)(L.G2t + c * 136 + part) = *(const v4u*)(LG + c * 128 + part); }
}
__device__ __forceinline__ ScanCh scan_ch(const Args& a, int l, int dir, int hc) {
    ScanCh c; c.kkw = a.in[19][l * 512 + hc]; c.kaw = a.in[20][l * 512 + hc]; c.rkw = a.in[21][l * 512 + hc]; c.w0v = a.in[14][(l * 2 + dir) * 512 + hc]; c.a0v = a.in[16][(l * 2 + dir) * 512 + hc]; return c;
}
__device__ __forceinline__ int seg_len(int b) { return b == 16 ? 512 : 1024; }
__device__ __forceinline__ int scan_item_of(int b, int h, int dir, int s) { const int hd = h * 2 + dir; return b == 16 ? hd * 32 + s : 512 + (b * 16 + hd) * 2 + s; }

template <int NV> __device__ __forceinline__ void scan_pass1(LAS unsigned char* lds, const Args& a, int l, int it, int tid, int wave, int lane) {
    int b, h, dir, s;
    if (NV == 64) { b = it >> 4; const int hd = it & 15; h = hd >> 1; dir = hd & 1; s = 0; }
    else { const int j = it - 256; const int hd = j / 31; s = j - hd * 31; b = 16; h = hd >> 1; dir = hd & 1; }
    const int s0 = b < 16 ? b * 2048 : 32768, len = b < 16 ? 2048 : 16384, SEGL = NV == 64 ? 1024 : 512;
    const bf16* P = (const bf16*)(a.ws + WS_P); const float* mu = a.in[13] + (size_t)l * 2 * 1920;
    const ScanLds L = scan_lds<NV>(lds); const ScanCh ch = scan_ch(a, l, dir, h * 64 + 16 * (wave & 3) + (lane & 15));
    Raw R; raw_load<false>(R, P, s0, len, dir ? len - 32 - s * SEGL : s * SEGL, h, dir, false, tid);
    scan_load_lora(L, a, l, dir, h, tid);
    if (NV == 128) { for (int e = tid; e < 64 * 20; e += NTHR) ((LAS unsigned*)(L.Vt + 64 * 40))[e] = 0u; }
    const int l31 = lane & 31, hi = lane >> 5, kt = wave & 1, vt = NV == 128 ? (wave >> 1) : ((wave >> 1) & 1); const bool hasT = NV == 128 ? true : wave >= 4;
    f32x16 st;
#pragma unroll
    for (int r = 0; r < 16; ++r) st[r] = (NV == 128 && (32 * vt + l31 - 64 == 32 * kt + mrow(r, hi))) ? 1.f : 0.f;
    for (int bt = 0; bt < SEGL / 32; ++bt) {
        const int n1 = s * SEGL + 32 * (bt + 1); const int pos1 = dir ? len - 32 - n1 : n1;
        scan_prep<NV, false>(L, R, P, mu, s0, len, pos1, bt + 1 < SEGL / 32, h, dir, ch, false, tid, wave, lane);
        scan_chunk<NV, false>(L, st, hasT, kt, vt, wave, lane);
    }
    float* AB = (float*)(a.ws + WS_AB) + (size_t)scan_item_of(b, h, dir, s) * 8192;
    if (hasT) { const int v = 32 * vt + l31; float* dst = v >= 64 ? AB + (v - 64) * 64 : AB + 4096 + v * 64;
#pragma unroll
      for (int g = 0; g < 4; ++g) *(f32x4*)(dst + 32 * kt + 8 * g + 4 * hi) = (f32x4){st[4 * g], st[4 * g + 1], st[4 * g + 2], st[4 * g + 3]}; }
    __syncthreads();
}
__device__ __forceinline__ void scan_pass2(LAS unsigned char* lds, const Args& a, int id, int tid) {
    int b, hd; if (id < 16) { b = 16; hd = id; } else { b = (id - 16) >> 4; hd = (id - 16) & 15; }
    const int v = tid >> 3, kq = (tid & 7) * 8;
    if (b < 16) {
        float* AB = (float*)(a.ws + WS_AB) + (size_t)(512 + (b * 16 + hd) * 2) * 8192;
        const f32x4 c0 = *(const f32x4*)(AB + 4096 + v * 64 + kq), c1 = *(const f32x4*)(AB + 4096 + v * 64 + kq + 4);
        *(f32x4*)(AB + 8192 + 4096 + v * 64 + kq) = c0; *(f32x4*)(AB + 8192 + 4096 + v * 64 + kq + 4) = c1;
        *(f32x4*)(AB + 4096 + v * 64 + kq) = (f32x4){0.f, 0.f, 0.f, 0.f}; *(f32x4*)(AB + 4096 + v * 64 + kq + 4) = (f32x4){0.f, 0.f, 0.f, 0.f};
        return;
    }
    const int nseg = 32; const int it0 = hd * 32;
    LAS float* Sm = (LAS float*)lds;
    LAS float* Am = (LAS float*)(lds + 32768);
    const int wave = tid >> 6, lane = tid & 63, l31 = lane & 31, hi = lane >> 5, vtl = (wave >> 1) & 1, ktl = wave & 1;
    __syncthreads();
    for (int e = tid; e < 64 * 65; e += NTHR) Sm[e] = 0.f;
    for (int s = 0; s < nseg; ++s) {
        float* AB = (float*)(a.ws + WS_AB) + (size_t)(it0 + s) * 8192;
        __syncthreads();
        if (s == nseg - 1) { *(f32x4*)(AB + 4096 + v * 64 + kq) = (f32x4){Sm[v * 65 + kq], Sm[v * 65 + kq + 1], Sm[v * 65 + kq + 2], Sm[v * 65 + kq + 3]};
                             *(f32x4*)(AB + 4096 + v * 64 + kq + 4) = (f32x4){Sm[v * 65 + kq + 4], Sm[v * 65 + kq + 5], Sm[v * 65 + kq + 6], Sm[v * 65 + kq + 7]}; break; }
        { const f32x4 a0 = *(const f32x4*)(AB + tid * 8), a1 = *(const f32x4*)(AB + tid * 8 + 4); *(LAS f32x4*)(Am + tid * 8) = a0; *(LAS f32x4*)(Am + tid * 8 + 4) = a1; }
        f32x16 acc;
        if (wave < 4) {
#pragma unroll
            for (int r = 0; r < 16; ++r) acc[r] = AB[4096 + (32 * vtl + mrow(r, hi)) * 64 + 32 * ktl + l31];
        }
        __syncthreads();
        *(f32x4*)(AB + 4096 + v * 64 + kq) = (f32x4){Sm[v * 65 + kq], Sm[v * 65 + kq + 1], Sm[v * 65 + kq + 2], Sm[v * 65 + kq + 3]};
        *(f32x4*)(AB + 4096 + v * 64 + kq + 4) = (f32x4){Sm[v * 65 + kq + 4], Sm[v * 65 + kq + 5], Sm[v * 65 + kq + 6], Sm[v * 65 + kq + 7]};
        if (wave < 4) {
#pragma unroll 8
            for (int ks = 0; ks < 32; ++ks) acc = __builtin_amdgcn_mfma_f32_32x32x2f32(Sm[(32 * vtl + l31) * 65 + 2 * ks + hi], Am[(2 * ks + hi) * 64 + 32 * ktl + l31], acc, 0, 0, 0);
        }
        __syncthreads();
        if (wave < 4) {
#pragma unroll
            for (int r = 0; r < 16; ++r) Sm[(32 * vtl + mrow(r, hi)) * 65 + 32 * ktl + l31] = acc[r];
        }
    }
    __syncthreads();
}
__device__ __forceinline__ void scan_pass3(LAS unsigned char* lds, const Args& a, int l, int it, int tid, int wave, int lane) {
    int b, h, ts; if (it < 256) { ts = it & 1; h = (it >> 1) & 7; b = it >> 4; } else { const int j = it - 256; b = 16; ts = j & 31; h = j >> 5; }
    const int s0 = b < 16 ? b * 2048 : 32768, len = b < 16 ? 2048 : 16384, SEG = seg_len(b), nseg = len / SEG;
    const bf16* P = (const bf16*)(a.ws + WS_P); bf16* Y = (bf16*)(a.ws + WS_XN); const float* mu = a.in[13] + (size_t)l * 2 * 1920;
    const ScanLds L = scan_lds<64>(lds);
    const int hc = h * 64 + lane;
    const float lxw = a.in[22][l * 512 + hc], lxb = a.in[23][l * 512 + hc];
    __syncthreads();
    scan_load_g2(L, a, h, tid);
    const int l31 = lane & 31, hi = lane >> 5, kt = wave & 1, vt = (wave >> 1) & 1; const bool hasT = wave >= 4;
    float* SB0 = (float*)(a.ws + WS_SB);
    for (int dir = 0; dir < 2; ++dir) {
        const ScanCh ch = scan_ch(a, l, dir, h * 64 + 16 * (wave & 3) + (lane & 15));
        const int s = dir ? nseg - 1 - ts : ts;
        Raw R; raw_load<true>(R, P, s0, len, dir ? len - 32 - s * SEG : s * SEG, h, dir, dir == 1, tid);
        scan_load_lora(L, a, l, dir, h, tid);
        const float* Sst = (const float*)(a.ws + WS_AB) + (size_t)scan_item_of(b, h, dir, s) * 8192 + 4096;
        f32x16 st;
#pragma unroll
        for (int g = 0; g < 4; ++g) { const f32x4 x = *(const f32x4*)(Sst + (32 * vt + l31) * 64 + 32 * kt + 8 * g + 4 * hi); st[4 * g] = x.x; st[4 * g + 1] = x.y; st[4 * g + 2] = x.z; st[4 * g + 3] = x.w; }
        for (int bt = 0; bt < SEG / 32; ++bt) {
            const int n0 = s * SEG + 32 * bt; const int pos0 = dir ? len - 32 - n0 : n0;
            const int n1 = n0 + 32; const int pos1 = dir ? len - 32 - n1 : n1;
            scan_prep<64, true>(L, R, P, mu, s0, len, pos1, bt + 1 < SEG / 32, h, dir, ch, dir == 1, tid, wave, lane);
            if (dir == 0) {
                scan_chunk<64, true>(L, st, hasT, kt, vt, wave, lane, Y + (size_t)(s0 + pos0) * 1024 + 512 + h * 64);
                if (tid < 32) SB0[(size_t)(s0 + pos0 + tid) * 8 + h] = L.SBs[tid];
            } else {
                float ypk[4], sbp[4];
#pragma unroll
                for (int tt = 0; tt < 4; ++tt) { const size_t row = (size_t)(s0 + pos0 + 31 - (wave * 4 + tt)); ypk[tt] = ldbf(Y + row * 1024 + 512 + hc); sbp[tt] = SB0[row * 8 + h]; }
                scan_chunk<64, true>(L, st, hasT, kt, vt, wave, lane);
                __syncthreads();
#pragma unroll
                for (int tt = 0; tt < 4; ++tt) { const int t = wave * 4 + tt; const size_t row = (size_t)(s0 + pos0 + 31 - t);
                    const float y = L.Ys[t * 64 + lane] + ypk[tt];
                    const float m = wave_sum(y) * (1.f / 64.f); const float d = y - m; const float var = wave_sum(d * d) * (1.f / 64.f);
                    const float yn = d * rsqrtf(var + GN_EPS_F) * lxw + lxb;
                    const float bonus = (L.SBs[t] + sbp[tt]) * L.Vs[t * 64 + lane];
                    Y[row * 1024 + 512 + hc] = (bf16)f2bf((yn + bonus) * bf2f((unsigned)L.GVb[t * 64 + lane])); }
            }
        }
        __threadfence();
    }
    __syncthreads();
}

#define XB_TMO      128
#define XB_XCNT(j)  (256  + 64 * (j))
#define XB_XSUB(j)  (1280 + 64 * (j))
#define XB_XGEN(j)  (2304 + 64 * (j))
#define XB_TOP      3328
#define XB_TOPGEN   3392
#define XCD_BAR_WORDS 3456
#define XB_SPIN_CAP (1u << 22)

__device__ __forceinline__ unsigned xb_ld(unsigned* p)              { return __hip_atomic_load(p, __ATOMIC_RELAXED, __HIP_MEMORY_SCOPE_AGENT); }
__device__ __forceinline__ unsigned xb_add(unsigned* p, unsigned v) { return __hip_atomic_fetch_add(p, v, __ATOMIC_RELAXED, __HIP_MEMORY_SCOPE_AGENT); }
__device__ __forceinline__ unsigned xb_xcc_id() { return (unsigned)__builtin_amdgcn_s_getreg((3 << 11) | 20) & 0xFu; }
#define XB_SPIN(cond, bar) do { unsigned _sp = 0; while (cond) { __builtin_amdgcn_s_sleep(1); \
    if ((++_sp & 255u) == 0u) { if (xb_ld(&(bar)[XB_TMO])) break; if (_sp > XB_SPIN_CAP) { atomicAdd(&(bar)[XB_TMO], 1u); break; } } } } while (0)

struct XcdBarrier {
    unsigned* bar; unsigned x;
    volatile LAS unsigned* st;
};

__device__ __forceinline__ XcdBarrier xcd_barrier_post(unsigned* bar, volatile LAS unsigned* st) {
    XcdBarrier b; b.bar = bar; b.x = xb_xcc_id(); b.st = st;
    if (threadIdx.x == 0) (void)xb_add(&bar[XB_XCNT(b.x)], 1u);
    return b;
}
__device__ __forceinline__ void xcd_barrier_complete(unsigned* bar, unsigned x, unsigned& nloc, unsigned& nx) {
    const unsigned G = gridDim.x * gridDim.y * gridDim.z;
    unsigned sum, cnt, mine, sp = 0u;
    for (;;) {
        sum = 0u; cnt = 0u; mine = 0u;
#pragma unroll
        for (unsigned j = 0; j < 16; ++j) { const unsigned c = xb_ld(&bar[XB_XCNT(j)]); sum += c; cnt += (c > 0u) ? 1u : 0u; mine = (j == x) ? c : mine; }
        if (sum == G) break;
        __builtin_amdgcn_s_sleep(1);
        if ((++sp & 255u) == 0u) { if (xb_ld(&bar[XB_TMO])) break; if (sp > XB_SPIN_CAP) { atomicAdd(&bar[XB_TMO], 1u); break; } }
    }
    nloc = mine > 0u ? mine : 1u; nx = cnt > 0u ? cnt : 1u;
}

__device__ __forceinline__ void xcd_barrier(const XcdBarrier& b) {
    asm volatile("s_waitcnt vmcnt(0)" ::: "memory");
    __syncthreads();
    if (threadIdx.x == 0) {
        unsigned* bar = b.bar;
        __builtin_amdgcn_s_waitcnt(0);
        unsigned nloc = b.st[0], nx = b.st[1];
        if (nloc == 0u) { xcd_barrier_complete(bar, b.x, nloc, nx); b.st[0] = nloc; b.st[1] = nx; }
        const unsigned old = xb_add(&bar[XB_XSUB(b.x)], 1u);
        const unsigned gen = old / nloc;
        if (old + 1u == (gen + 1u) * nloc) {
            __builtin_amdgcn_fence(__ATOMIC_RELEASE, "agent");
            asm volatile("s_waitcnt vmcnt(0)" ::: "memory");
            const unsigned og = xb_add(&bar[XB_TOP], 1u);
            const unsigned tg = og / nx;
            if (og + 1u == (tg + 1u) * nx) xb_add(&bar[XB_TOPGEN], 1u);
            else XB_SPIN(xb_ld(&bar[XB_TOPGEN]) == tg, bar);
            __builtin_amdgcn_fence(__ATOMIC_ACQUIRE, "agent");
            xb_add(&bar[XB_XGEN(b.x)], 1u);
            asm volatile("s_waitcnt vmcnt(0)" ::: "memory");
        } else {
            XB_SPIN(xb_ld(&bar[XB_XGEN(b.x)]) == gen, bar);
            __builtin_amdgcn_fence(__ATOMIC_ACQUIRE, "agent");
            asm volatile("s_waitcnt vmcnt(0)" ::: "memory");
        }
    }
    __syncthreads();
}

#ifndef G1_ON
#define G1_ON 1
#endif
#ifndef G2_ON
#define G2_ON 1
#endif
#ifndef G3_ON
#define G3_ON 1
#endif
#ifndef G4_ON
#define G4_ON 1
#endif
#if defined(__HIP_DEVICE_COMPILE__)
#define LOAD_ARGS() const __attribute__((address_space(4))) unsigned char* kp_ = (const __attribute__((address_space(4))) unsigned char*)__builtin_amdgcn_kernarg_segment_ptr(); asm volatile("" : "+s"(kp_)); const Args a = *(const __attribute__((address_space(4))) Args*)kp_
#else
#define LOAD_ARGS() const Args a = a0
#endif
template <bool COOP>
__global__ void __launch_bounds__(NTHR, 2) fwd_kernel(Args a0) {
    extern __shared__ __attribute__((aligned(16))) unsigned char lds_raw[];
    LAS unsigned char* lds = (LAS unsigned char*)lds_raw;
    const int G = gridDim.x, NGW = G * NWAVES;
    const int wave0 = __builtin_amdgcn_readfirstlane((int)threadIdx.x >> 6);
#define TIDS() int lane_ = (int)__builtin_amdgcn_mbcnt_hi(~0u, __builtin_amdgcn_mbcnt_lo(~0u, 0u)); asm volatile("" : "+v"(lane_)); const int lane = lane_, wave = wave0, tid = wave0 * 64 + lane, gw = blockIdx.x * NWAVES + wave; (void)gw; (void)lane; (void)tid; LOAD_ARGS()
    cg::grid_group grid = cg::this_grid();
    const int ph_lo = a0.ph_lo, ph_hi = a0.ph_hi;
#define RUN(k) (ph_lo <= (k) && (k) < ph_hi)
    XcdBarrier xbar; xbar.bar = (unsigned*)a0.ws; xbar.x = 0; xbar.st = (volatile LAS unsigned*)(lds + 147392);
    if (COOP) { if (threadIdx.x == 0) { xbar.st[0] = 0u; xbar.st[1] = 0u; } __syncthreads(); xbar = xcd_barrier_post((unsigned*)a0.ws, (volatile LAS unsigned*)(lds + 147392)); }
#define SEAM(k) do { if (COOP) { if (RUN(k) && RUN((k) + 1)) { if ((k) == 0) grid.sync(); else xcd_barrier(xbar); } } } while (0)
#define P_X (a.out)
#define P_XN ((bf16*)(a.ws + WS_XN))
#define P_PB ((bf16*)(a.ws + WS_P))
#define P_MODL ((const float*)(a.ws + WS_MOD) + (size_t)l * 17 * NMOD)
#define P_XA (l == 0 ? a.in[0] : (const float*)a.out)
#define P_XB (l == 0 ? a.in[1] : (const float*)a.out + (size_t)32768 * 1024)
    if (RUN(0)) { TIDS(); mod_phase(a, lds, tid); }
    SEAM(0);
#pragma unroll 1
    for (int l = 0; l < NLAYER; ++l) {
        const int pb = 1 + 9 * l;
        if (RUN(pb + 0)) { TIDS(); convert_weights(a, l, lds, gw, NGW, wave, lane); norm_phase(P_XA, P_XB, a.in[6] + l * 1024, P_MODL, 0, 1024, P_XN, gw, NGW, lane); }
        SEAM(pb + 0);
        if (RUN(pb + 1)) { TIDS(); pg8::Gemm g{P_XN, (const bf16*)(a.ws + WS_WIN), MTOK, PLD, 1024}; pg8::StaticOrder S; S.init(MTOK, PLD, G, (int)blockIdx.x);
            pg8::EpiBf16 E{P_PB, PLD}; pg8::gemm_phase<pg8::EpiBf16, pg8::StaticOrder, true, true>(lds, g, S, E, tid); }
        SEAM(pb + 1);
        if (RUN(pb + 2)) { TIDS(); for (int it = blockIdx.x; it < 752; it += G) { if (it < 256) scan_pass1<64>(lds, a, l, it, tid, wave, lane); else scan_pass1<128>(lds, a, l, it, tid, wave, lane); } }
        SEAM(pb + 2);
        if (RUN(pb + 3)) { TIDS(); for (int id = 16 + blockIdx.x; id < 272; id += G) scan_pass2(lds, a, id, tid);
            if (G > 32) { if (blockIdx.x < 16) scan_pass2(lds, a, (int)blockIdx.x, tid); else for (int it = blockIdx.x - 16; it < 1536; it += G - 16) mixer_a_item(lds, a, l, it, tid, wave, lane); }
            else { for (int it = blockIdx.x; it < 16 + 1536; it += G) { if (it < 16) scan_pass2(lds, a, it, tid); else mixer_a_item(lds, a, l, it - 16, tid, wave, lane); } } }
        SEAM(pb + 3);
        if (RUN(pb + 4)) { TIDS(); for (int it = blockIdx.x; it < 512; it += G) scan_pass3(lds, a, l, it, tid, wave, lane); }
        SEAM(pb + 4);
        if (RUN(pb + 5)) { TIDS(); pg8::Gemm g{P_XN, (const bf16*)(a.ws + WS_WOUT), MTOK, 1024, 1024}; pg8::StaticOrder S; S.init(MTOK, 1024, G, (int)blockIdx.x);
            pg8::EpiRes E{P_XA, P_XB, P_X, P_MODL + 2048}; pg8::gemm_phase<pg8::EpiRes, pg8::StaticOrder, true, true>(lds, g, S, E, tid); }
        SEAM(pb + 5);
        if (RUN(pb + 6)) { TIDS(); norm_phase(P_X, P_X + (size_t)32768 * 1024, a.in[25] + l * 1024, P_MODL, 3072, 4096, P_XN, gw, NGW, lane); }
        SEAM(pb + 6);
        if (RUN(pb + 7)) { TIDS(); pg8::Gemm g{P_XN, (const bf16*)(a.ws + WS_WGU), MTOK, 5632, 1024}; pg8::StaticOrder S; S.init(MTOK, 5632, G, (int)blockIdx.x);
            pg8::EpiSwiGLU E{P_PB}; pg8::gemm_phase<pg8::EpiSwiGLU, pg8::StaticOrder, true, true>(lds, g, S, E, tid); }
        SEAM(pb + 7);
        if (RUN(pb + 8)) { TIDS(); pg8::Gemm g{P_PB, (const bf16*)(a.ws + WS_WDN), MTOK, 1024, DFF}; pg8::StaticOrder S; S.init(MTOK, 1024, G, (int)blockIdx.x);
            pg8::EpiRes E{P_X, P_X + (size_t)32768 * 1024, P_X, P_MODL + 5120}; pg8::gemm_phase<pg8::EpiRes, pg8::StaticOrder, true, true>(lds, g, S, E, tid); }
        SEAM(pb + 8);
    }
    if (RUN(37)) { TIDS(); final_norm_phase(P_X, a.in[28], gw, NGW, lane); }
#undef RUN
#undef SEAM
}
constexpr int N_PHASES = 38;
#ifndef MK_COOP
#define MK_COOP 1
#endif

extern "C" void kernel_launch(void* const* d_in, const int* in_sizes, int n_in, void* d_out, int out_size, void* d_ws, size_t ws_size, hipStream_t stream) {
    static int grid = 0;
    if (grid == 0) {
        if (n_in != 29 || out_size != MTOK * DM || ws_size < WS_END) { fprintf(stderr, "kernel_launch: unexpected shapes n_in %d out %d ws %zu (need %zu)\n", n_in, out_size, ws_size, (size_t)WS_END); grid = -1; return; }
        int dev = 0, cus = 0, per_cu = 0;
        hipGetDevice(&dev); hipDeviceGetAttribute(&cus, hipDeviceAttributeMultiprocessorCount, dev);
        hipFuncSetAttribute((const void*)fwd_kernel<true>, hipFuncAttributeMaxDynamicSharedMemorySize, LDS_BYTES);
        hipFuncSetAttribute((const void*)fwd_kernel<false>, hipFuncAttributeMaxDynamicSharedMemorySize, LDS_BYTES);
        hipOccupancyMaxActiveBlocksPerMultiprocessor(&per_cu, (const void*)fwd_kernel<true>, NTHR, LDS_BYTES);
        if (per_cu < 1) per_cu = 1;
        (void)hipGetLastError();
        grid = cus * per_cu;
    }
    if (grid < 0) return;
#if MK_COOP
    if (hipMemsetAsync(d_ws, 0, 16384, stream) != hipSuccess) { fprintf(stderr, "kernel_launch: memset of the barrier words failed\n"); return; }
#endif
    Args a{};
    for (int i = 0; i < 29; ++i) a.in[i] = (const float*)d_in[i];
    a.out = (float*)d_out; a.ws = (unsigned char*)d_ws;
#if MK_COOP
    a.ph_lo = 0; a.ph_hi = N_PHASES;
    void* args[] = {&a};
    hipError_t e = hipLaunchCooperativeKernel((const void*)fwd_kernel<true>, dim3(grid), dim3(NTHR), args, LDS_BYTES, stream);
    if (e != hipSuccess) fprintf(stderr, "cooperative launch failed: %s (grid %d)\n", hipGetErrorString(e), grid);
#else
    for (int p = 0; p < N_PHASES; ++p) { a.ph_lo = p; a.ph_hi = p + 1; hipLaunchKernelGGL(fwd_kernel<false>, dim3(grid), dim3(NTHR), LDS_BYTES, stream, a); }
#endif
}
```
